# Optimizing an MI355X kernel written in HIP

```python
import math
import jax
import jax.numpy as jnp
from jax import lax
import numpy as np

D_MODEL = 4096
BATCH = 16
SEQ = 256
DEPTH = 2
DEC_BATCH = 2
DEC_SEQ = 1024
PAST_LEN = 256

GRID_W = 64
W_BR = D_MODEL // 2
S5_GROUP = 16
S5_GROUPS = W_BR // S5_GROUP
S5_STATE = 64
LRU_BLOCKS = 16
LRU_BW = W_BR // LRU_BLOCKS
LRU_C = 8.0
CONV_W = 4
HG_DK = 128
HG_HEADS = W_BR // HG_DK
HG_DV = W_BR // HG_HEADS
HG_CHUNK = 16
N_BRANCH = 3
IN_COLS = 9 * W_BR + N_BRANCH * D_MODEL
DN_ALPHA = (2 * DEPTH) ** 0.25
DN_BETA = (8 * DEPTH) ** -0.25
LN_EPS = 1e-5
RMS_EPS = 1e-6

kernel_name = "hybrid_s5_rglru_hgrn2_diffusion_step"


def layer_norm(x):
    xf = x.astype(jnp.float32)
    mu = jnp.mean(xf, axis=-1, keepdims=True)
    var = jnp.mean(jnp.square(xf - mu), axis=-1, keepdims=True)
    return ((xf - mu) * lax.rsqrt(var + LN_EPS)).astype(x.dtype)


def layer_norm_affine(x, g, b):
    xf = x.astype(jnp.float32)
    mu = jnp.mean(xf, axis=-1, keepdims=True)
    var = jnp.mean(jnp.square(xf - mu), axis=-1, keepdims=True)
    y = (xf - mu) * lax.rsqrt(var + LN_EPS) * g.astype(jnp.float32) + b.astype(jnp.float32)
    return y.astype(x.dtype)


def _real_combine(left, right):
    a_l, b_l = left
    a_r, b_r = right
    return a_l * a_r, a_r * b_l + b_r


def real_linear_scan(a, b, h0, reverse):
    if reverse:
        a = jnp.flip(a, axis=1)
        b = jnp.flip(b, axis=1)
    b = b.at[:, 0].add(a[:, 0] * h0)
    _, h = lax.associative_scan(_real_combine, (a, b), axis=1)
    h_final = h[:, -1]
    if reverse:
        h = jnp.flip(h, axis=1)
    return h, h_final


def _complex_combine(left, right):
    ar_l, ai_l, br_l, bi_l = left
    ar_r, ai_r, br_r, bi_r = right
    return (ar_r * ar_l - ai_r * ai_l,
            ar_r * ai_l + ai_r * ar_l,
            ar_r * br_l - ai_r * bi_l + br_r,
            ar_r * bi_l + ai_r * br_l + bi_r)


def complex_linear_scan(lam_re, lam_im, b_re, b_im, h0_re, h0_im, reverse):
    if reverse:
        b_re = jnp.flip(b_re, axis=1)
        b_im = jnp.flip(b_im, axis=1)
    b_re = b_re.at[:, 0].add(lam_re * h0_re - lam_im * h0_im)
    b_im = b_im.at[:, 0].add(lam_re * h0_im + lam_im * h0_re)
    a_re = jnp.broadcast_to(lam_re, b_re.shape)
    a_im = jnp.broadcast_to(lam_im, b_im.shape)
    _, _, h_re, h_im = lax.associative_scan(_complex_combine, (a_re, a_im, b_re, b_im), axis=1)
    last_re, last_im = h_re[:, -1], h_im[:, -1]
    if reverse:
        h_re = jnp.flip(h_re, axis=1)
        h_im = jnp.flip(h_im, axis=1)
    return h_re, h_im, last_re, last_im


def s5_mixer(u, a_re, a_im, log_dt, b_re, b_im, c_re, c_im, d_skip, w_glu, b_glu, h0):
    f32 = jnp.float32
    bsz, seqlen, _ = u.shape
    uf = u.astype(f32)
    ug = uf.reshape(bsz, seqlen, S5_GROUPS, S5_GROUP)
    bu_re = jnp.einsum('blgc,gpc->blgp', ug, b_re.astype(f32))
    bu_im = jnp.einsum('blgc,gpc->blgp', ug, b_im.astype(f32))
    h0f = h0.astype(f32)
    y = uf * d_skip.astype(f32)
    finals = []
    for dr in range(2):
        ar = jnp.minimum(a_re[dr].astype(f32), -1e-4)
        ai = a_im[dr].astype(f32)
        dt = jnp.exp(log_dt[dr].astype(f32))[:, None]
        mag = jnp.exp(dt * ar)
        lam_re = mag * jnp.cos(dt * ai)
        lam_im = mag * jnp.sin(dt * ai)
        den = ar * ar + ai * ai
        z_re = ((lam_re - 1.0) * ar + lam_im * ai) / den
        z_im = (lam_im * ar - (lam_re - 1.0) * ai) / den
        x_re = z_re * bu_re - z_im * bu_im
        x_im = z_re * bu_im + z_im * bu_re
        h_re, h_im, last_re, last_im = complex_linear_scan(
            lam_re, lam_im, x_re, x_im, h0f[:, dr, :, :, 0], h0f[:, dr, :, :, 1], dr == 1)
        y_dir = (jnp.einsum('blgp,gcp->blgc', h_re, c_re.astype(f32))
                 - jnp.einsum('blgp,gcp->blgc', h_im, c_im.astype(f32)))
        y = y + y_dir.reshape(bsz, seqlen, W_BR)
        finals.append(jnp.stack([last_re, last_im], axis=-1))
    y = jax.nn.gelu(y)
    y = y * jax.nn.sigmoid(y @ w_glu.astype(f32) + b_glu.astype(f32))
    return y.astype(u.dtype), jnp.stack(finals, axis=1)


def dwconv_centred(x, w, b, axis):
    n = x.shape[axis]
    pad = [(0, 0)] * x.ndim
    pad[axis] = (CONV_W // 2, CONV_W - 1 - CONV_W // 2)
    xp = jnp.pad(x, pad)
    out = b
    for k in range(CONV_W):
        out = out + w[k] * lax.slice_in_dim(xp, k, k + n, axis=axis)
    return out


def rglru_mixer(xb, conv_w, conv_b, w_a, b_a, w_x, b_x, lam, h0, rows):
    f32 = jnp.float32
    bsz, seqlen, _ = xb.shape
    xf = xb.astype(f32)
    cw, cb = conv_w.astype(f32), conv_b.astype(f32)
    if rows is None:
        xc = dwconv_centred(xf, cw, cb, axis=1)
    else:
        xg = xf.reshape(bsz, rows, GRID_W, W_BR)
        xc = dwconv_centred(xg, cw, cb, axis=2).reshape(bsz, seqlen, W_BR)
    xblk = xc.reshape(bsz, seqlen, LRU_BLOCKS, LRU_BW)
    h0f = h0.astype(f32)
    outs, finals = [], []
    for dr in range(2):
        r = jax.nn.sigmoid(jnp.einsum('blnc,ncd->blnd', xblk, w_a[dr].astype(f32)).reshape(bsz, seqlen, W_BR)
                           + b_a[dr].astype(f32))
        ig = jax.nn.sigmoid(jnp.einsum('blnc,ncd->blnd', xblk, w_x[dr].astype(f32)).reshape(bsz, seqlen, W_BR)
                            + b_x[dr].astype(f32))
        log_a = -LRU_C * r * jax.nn.softplus(-lam[dr].astype(f32))
        a = jnp.exp(log_a)
        mult = jnp.sqrt(-jnp.expm1(2.0 * log_a))
        h, last = real_linear_scan(a, mult * (ig * xc), h0f[:, dr], dr == 1)
        outs.append(h)
        finals.append(last)
    y = outs[0] + outs[1]
    return y.astype(xb.dtype), jnp.stack(finals, axis=1)


def chunk_gated_linear(q, k, v, log_f, h0, reverse):
    if reverse:
        q, k, v, log_f = (jnp.flip(t, axis=1) for t in (q, k, v, log_f))
    bsz, seqlen, nh, dk = q.shape
    dv = v.shape[-1]
    nch = seqlen // HG_CHUNK

    def to_chunks(t):
        return jnp.moveaxis(t.reshape(bsz, nch, HG_CHUNK, nh, t.shape[-1]), 1, 0)

    cum = jnp.cumsum(log_f.reshape(bsz, nch, HG_CHUNK, nh, dk), axis=2)
    cum = jnp.moveaxis(cum, 1, 0)
    causal = jnp.tril(jnp.ones((HG_CHUNK, HG_CHUNK), dtype=bool))[None, :, :, None, None]

    def body(state, xs):
        qn, kn, vn, bn = xs
        b_last = bn[:, -1]
        diff = bn[:, :, None] - bn[:, None, :]
        dec = jnp.where(causal, jnp.exp(jnp.minimum(diff, 0.0)), 0.0)
        scores = jnp.einsum('btshk,bshk->bhts', qn[:, :, None] * dec, kn)
        o = (jnp.einsum('bhts,bshv->bthv', scores, vn)
             + jnp.einsum('bthk,bhkv->bthv', qn * jnp.exp(bn), state))
        k_dec = kn * jnp.exp(b_last[:, None] - bn)
        state = state * jnp.exp(b_last)[..., None] + jnp.einsum('bshk,bshv->bhkv', k_dec, vn)
        return state, o

    final, o = lax.scan(body, h0, (to_chunks(q), to_chunks(k), to_chunks(v), cum))
    o = jnp.moveaxis(o, 0, 1).reshape(bsz, seqlen, nh, dv)
    if reverse:
        o = jnp.flip(o, axis=1)
    return o, final


def hgrn2_mixer(q, f_fwd, f_bwd, v, lb, norm_w, h0):
    f32 = jnp.float32
    bsz, seqlen, _ = q.shape
    qf = jax.nn.silu(q.astype(f32)).reshape(bsz, seqlen, HG_HEADS, HG_DK)
    vf = v.astype(f32).reshape(bsz, seqlen, HG_HEADS, HG_DV)
    h0f = h0.astype(f32)
    outs, finals = [], []
    for dr, f in enumerate((f_fwd, f_bwd)):
        lbd = lb[dr].astype(f32)
        g = lbd + (1.0 - lbd) * jax.nn.sigmoid(f.astype(f32))
        log_g = jnp.log(g).reshape(bsz, seqlen, HG_HEADS, HG_DK)
        kf = (1.0 - g).reshape(bsz, seqlen, HG_HEADS, HG_DK)
        o, last = chunk_gated_linear(qf, kf, vf, log_g, h0f[:, dr], dr == 1)
        outs.append(o)
        finals.append(last)
    o = outs[0] + outs[1]
    o = o * lax.rsqrt(jnp.mean(jnp.square(o), axis=-1, keepdims=True) + RMS_EPS)
    o = o * norm_w.astype(f32).reshape(HG_HEADS, HG_DV)
    return o.reshape(bsz, seqlen, W_BR).astype(q.dtype), jnp.stack(finals, axis=1)


def trunk_layer(x, mod, h0_s5, h0_lru, h0_hg, rows, lb,
                w_in, b_in, s5_a_re, s5_a_im, s5_log_dt, s5_b_re, s5_b_im, s5_c_re, s5_c_im,
                s5_d, s5_w_glu, s5_b_glu, lru_conv_w, lru_conv_b, lru_w_a, lru_b_a, lru_w_x, lru_b_x,
                lru_lambda, hg_norm_w, w_br, w_out, b_out, ln_g, ln_b):
    shift, scale, gate = jnp.split(mod, 3, axis=-1)
    h = layer_norm(x) * (1.0 + scale) + shift
    proj = jnp.einsum('bld,dc->blc', h, w_in) + b_in
    sizes = [W_BR] * 9 + [D_MODEL] * N_BRANCH
    idx, acc = [], 0
    for s in sizes[:-1]:
        acc += s
        idx.append(acc)
    (u_a, g_a, x_b, g_b, q_c, f_c_fwd, f_c_bwd, i_c, g_c,
     m_a, m_b, m_c) = jnp.split(proj, idx, axis=-1)
    y_a, st_s5 = s5_mixer(u_a, s5_a_re, s5_a_im, s5_log_dt, s5_b_re, s5_b_im, s5_c_re, s5_c_im,
                          s5_d, s5_w_glu, s5_b_glu, h0_s5)
    y_b, st_lru = rglru_mixer(x_b, lru_conv_w, lru_conv_b, lru_w_a, lru_b_a, lru_w_x, lru_b_x,
                              lru_lambda, h0_lru, rows)
    y_c, st_hg = hgrn2_mixer(q_c, f_c_fwd, f_c_bwd, i_c, lb, hg_norm_w, h0_hg)
    y_a = y_a * jax.nn.silu(g_a)
    y_b = y_b * jax.nn.silu(g_b)
    y_c = y_c * jax.nn.silu(g_c)
    merged = (jax.nn.sigmoid(m_a) * jnp.einsum('blw,wd->bld', y_a, w_br[0])
              + jax.nn.sigmoid(m_b) * jnp.einsum('blw,wd->bld', y_b, w_br[1])
              + jax.nn.sigmoid(m_c) * jnp.einsum('blw,wd->bld', y_c, w_br[2]))
    out = jnp.einsum('bld,de->ble', merged, w_out) + b_out
    x_new = layer_norm_affine(DN_ALPHA * x + gate * out, ln_g, ln_b)
    return x_new, st_s5, st_lru, st_hg


def setup_inputs(seed: int = 0) -> dict:
    key = jax.random.key(seed)
    ks = iter(jax.random.split(key, 48))
    f32 = jnp.float32

    def nrm(shape, scale):
        return jax.random.normal(next(ks), shape, f32) * scale

    a_im_base = jnp.pi * jnp.arange(S5_STATE, dtype=f32)
    lru_u = jax.random.uniform(next(ks), (DEPTH, 2, W_BR), f32, minval=0.9, maxval=0.999)
    lru_a = lru_u ** (1.0 / LRU_C)
    return {
        "x_prompt": nrm((BATCH, SEQ, D_MODEL), 1.0),
        "x_sample": nrm((DEC_BATCH, DEC_SEQ, D_MODEL), 1.0),
        "state_s5": nrm((DEC_BATCH, DEPTH, 2, S5_GROUPS, S5_STATE, 2), 0.5),
        "state_lru": nrm((DEC_BATCH, DEPTH, 2, W_BR), 0.5),
        "state_hgrn": nrm((DEC_BATCH, DEPTH, 2, HG_HEADS, HG_DK, HG_DV), 0.5),
        "c": nrm((DEC_BATCH, D_MODEL), 1.0),
        "c_ctx": nrm((D_MODEL,), 1.0),
        "w_ada": nrm((DEPTH, D_MODEL, 3 * D_MODEL), D_MODEL ** -0.5),
        "b_ada": nrm((DEPTH, 3 * D_MODEL), 0.01),
        "w_in": nrm((DEPTH, D_MODEL, IN_COLS), D_MODEL ** -0.5),
        "b_in": nrm((DEPTH, IN_COLS), 0.01),
        "s5_a_re": -0.5 + nrm((DEPTH, 2, S5_GROUPS, S5_STATE), 0.01),
        "s5_a_im": a_im_base + nrm((DEPTH, 2, S5_GROUPS, S5_STATE), 0.01),
        "s5_log_dt": jax.random.uniform(next(ks), (DEPTH, 2, S5_GROUPS), f32,
                                        minval=math.log(1e-3), maxval=math.log(1e-1)),
        "s5_b_re": nrm((DEPTH, S5_GROUPS, S5_STATE, S5_GROUP), (2.0 * S5_GROUP) ** -0.5),
        "s5_b_im": nrm((DEPTH, S5_GROUPS, S5_STATE, S5_GROUP), (2.0 * S5_GROUP) ** -0.5),
        "s5_c_re": nrm((DEPTH, S5_GROUPS, S5_GROUP, S5_STATE), (2.0 * S5_STATE) ** -0.5),
        "s5_c_im": nrm((DEPTH, S5_GROUPS, S5_GROUP, S5_STATE), (2.0 * S5_STATE) ** -0.5),
        "s5_d": nrm((DEPTH, W_BR), 1.0),
        "s5_w_glu": nrm((DEPTH, W_BR, W_BR), W_BR ** -0.5),
        "s5_b_glu": nrm((DEPTH, W_BR), 0.01),
        "lru_conv_w": nrm((DEPTH, CONV_W, W_BR), CONV_W ** -0.5),
        "lru_conv_b": nrm((DEPTH, W_BR), 0.01),
        "lru_w_a": nrm((DEPTH, 2, LRU_BLOCKS, LRU_BW, LRU_BW), LRU_BW ** -0.5),
        "lru_b_a": nrm((DEPTH, 2, W_BR), 0.01),
        "lru_w_x": nrm((DEPTH, 2, LRU_BLOCKS, LRU_BW, LRU_BW), LRU_BW ** -0.5),
        "lru_b_x": nrm((DEPTH, 2, W_BR), 0.01),
        "lru_lambda": jnp.log(lru_a) - jnp.log1p(-lru_a),
        "hg_lb": nrm((DEPTH, 2, W_BR), 0.5),
        "hg_norm_w": 1.0 + nrm((DEPTH, W_BR), 0.01),
        "w_br": nrm((DEPTH, N_BRANCH, W_BR, D_MODEL), W_BR ** -0.5 * DN_BETA),
        "w_out": nrm((DEPTH, D_MODEL, D_MODEL), D_MODEL ** -0.5 * DN_BETA),
        "b_out": nrm((DEPTH, D_MODEL), 0.01),
        "ln_g": 1.0 + nrm((DEPTH, D_MODEL), 0.01),
        "ln_b": nrm((DEPTH, D_MODEL), 0.01),
    }


def reference(x_prompt, x_sample, state_s5, state_lru, state_hgrn, c, c_ctx,
              w_ada, b_ada, w_in, b_in, s5_a_re, s5_a_im, s5_log_dt, s5_b_re, s5_b_im,
              s5_c_re, s5_c_im, s5_d, s5_w_glu, s5_b_glu, lru_conv_w, lru_conv_b,
              lru_w_a, lru_b_a, lru_w_x, lru_b_x, lru_lambda, hg_lb, hg_norm_w,
              w_br, w_out, b_out, ln_g, ln_b):
    f32 = jnp.float32
    lb_soft = jax.nn.softmax(hg_lb.astype(f32), axis=0)
    lb_all = jnp.cumsum(lb_soft, axis=0) - lb_soft[0]

    def run_layer(l, x, mod, h0_s5, h0_lru, h0_hg, rows):
        return trunk_layer(x, mod, h0_s5, h0_lru, h0_hg, rows, lb_all[l],
                           w_in[l], b_in[l], s5_a_re[l], s5_a_im[l], s5_log_dt[l],
                           s5_b_re[l], s5_b_im[l], s5_c_re[l], s5_c_im[l], s5_d[l],
                           s5_w_glu[l], s5_b_glu[l], lru_conv_w[l], lru_conv_b[l],
                           lru_w_a[l], lru_b_a[l], lru_w_x[l], lru_b_x[l], lru_lambda[l],
                           hg_norm_w[l], w_br[l], w_out[l], b_out[l], ln_g[l], ln_b[l])

    nb = x_prompt.shape[0]
    z_s5 = jnp.zeros((nb, 2, S5_GROUPS, S5_STATE, 2), f32)
    z_lru = jnp.zeros((nb, 2, W_BR), f32)
    z_hg = jnp.zeros((nb, 2, HG_HEADS, HG_DK, HG_DV), f32)
    silu_ctx = jax.nn.silu(c_ctx)
    x = x_prompt
    st_s5_list, st_lru_list, st_hg_list = [], [], []
    for l in range(DEPTH):
        mod_ctx = (silu_ctx @ w_ada[l] + b_ada[l])[None, None, :]
        x, st_s5, st_lru, st_hg = run_layer(l, x, mod_ctx, z_s5, z_lru, z_hg, None)
        st_s5_list.append(st_s5)
        st_lru_list.append(st_lru)
        st_hg_list.append(st_hg)
    y_prompt = x
    new_state_s5 = jnp.stack(st_s5_list, axis=1).astype(x_prompt.dtype)
    new_state_lru = jnp.stack(st_lru_list, axis=1).astype(x_prompt.dtype)
    new_state_hgrn = jnp.stack(st_hg_list, axis=1).astype(x_prompt.dtype)

    rows = x_sample.shape[1] // GRID_W
    silu_c = jax.nn.silu(c)
    x = x_sample
    for l in range(DEPTH):
        mod_lat = (silu_c @ w_ada[l] + b_ada[l])[:, None, :]
        x, _, _, _ = run_layer(l, x, mod_lat, state_s5[:, l], state_lru[:, l], state_hgrn[:, l], rows)
    y_sample = x

    return (y_prompt, y_sample, new_state_s5, new_state_lru, new_state_hgrn)
```

```cpp
#include <hip/hip_runtime.h>
#include <cstdio>
#include <cstdint>

#ifndef MK_N_LAUNCHES
#define MK_N_LAUNCHES 1
#endif

#ifndef PROBE_MASK
#define PROBE_MASK 0u
#endif
#define REP(k) for (int _r = 0; _r < (int)(((PROBE_MASK) >> (k)) & 1u) + 1; ++_r)
#define LAS __attribute__((address_space(3)))
#define GAS __attribute__((address_space(1)))
typedef unsigned short bf16;
typedef short bf16x8 __attribute__((ext_vector_type(8)));
typedef short bf16x4 __attribute__((ext_vector_type(4)));
typedef float f32x4 __attribute__((ext_vector_type(4)));
typedef float f32x2 __attribute__((ext_vector_type(2)));
typedef unsigned u32x4 __attribute__((ext_vector_type(4)));
typedef unsigned u32x2 __attribute__((ext_vector_type(2)));

constexpr int D = 4096, WB = 2048, NTOK = 6144, NCTX = 4096, INC = 30720;
constexpr int NSEQ = 18;
constexpr float LN_EPS = 1e-5f, RMS_EPS = 1e-6f, DN_ALPHA = 1.41421356237f;

constexpr size_t MiB = 1u << 20;
constexpr size_t WS_CTL = 0, CTL_ZERO_BYTES = 1 * MiB;
constexpr size_t WS_MOD = 1 * MiB;
constexpr size_t WS_WLRU = 2 * MiB;
constexpr size_t WS_WGLU = 6 * MiB;
constexpr size_t WS_WBR = 22 * MiB;
constexpr size_t WS_WOUT = 118 * MiB;
constexpr size_t WS_WIN = 182 * MiB;
constexpr size_t WS_H = 662 * MiB;
constexpr size_t WS_PROJ = 710 * MiB;
constexpr size_t WS_YS5 = 1070 * MiB;
constexpr size_t WS_HL = 1166 * MiB;
constexpr size_t WS_O = 1262 * MiB;
constexpr size_t WS_YAP = 1358 * MiB;
constexpr size_t WS_YABC = 1382 * MiB;
constexpr size_t WS_TMP = 1454 * MiB;
constexpr size_t WS_MERGED = 1550 * MiB;
constexpr size_t WS_V = 1598 * MiB;
constexpr size_t WS_X1 = 1694 * MiB;
constexpr size_t WS_SLAB = 1790 * MiB;
constexpr size_t WS_END = 1854 * MiB;
constexpr size_t SEG_ELEMS = (size_t)NTOK * WB;
constexpr int CW_TMO = 0;
constexpr int CW_MIXQ = 1024;
constexpr int CW_BAR = 4096;
constexpr int CW_CNT = 16384;

constexpr int RING_BYTES = 131072;
constexpr int LDSCTL_OFF = RING_BYTES;
constexpr int LDS_BYTES = 147456;

__host__ __device__ __forceinline__ bool seg_is_fp8(int seg) { return seg >= 9; }
__host__ __device__ __forceinline__ int seg_local(int seg) { return seg_is_fp8(seg) ? seg - 9 : seg; }
__host__ __device__ __forceinline__ int seg_of_b(int bi) { return bi; }
__host__ __device__ __forceinline__ int seg_of_g(int gi) { return gi + 9; }
constexpr float W8_SCALE = 64.f;
__device__ __forceinline__ float bf2f(bf16 b) { return __uint_as_float(((unsigned)b) << 16); }
__device__ __forceinline__ float bflo(unsigned w) { return __uint_as_float(w << 16); }
__device__ __forceinline__ float bfhi(unsigned w) { return __uint_as_float(w & 0xffff0000u); }
typedef __bf16 bf16x2_t __attribute__((ext_vector_type(2)));
__device__ __forceinline__ unsigned cvt_pk_bf16(float lo, float hi) { const bf16x2_t v = {(__bf16)lo, (__bf16)hi}; return __builtin_bit_cast(unsigned, v); }
__device__ __forceinline__ bf16 f2bf(float f) { return (bf16)(cvt_pk_bf16(f, 0.f) & 0xffffu); }
__device__ __forceinline__ float frcp(float x) { return __builtin_amdgcn_rcpf(x); }
__device__ __forceinline__ float sigm(float x) { return frcp(1.f + __expf(-x)); }
__device__ __forceinline__ float siluf(float x) { return x * sigm(x); }
__device__ __forceinline__ float gelu_tanh(float y) { return y * sigm(1.5957691216f * (y + 0.044715f * y * y * y)); }
__device__ __forceinline__ float shfl_src(float v, int src) { return __builtin_bit_cast(float, __builtin_amdgcn_ds_bpermute(src << 2, __builtin_bit_cast(int, v))); }
#define SHFL_XOR(v, m, ln)  shfl_src((v), (ln) ^ (m))
#define SHFL_UP(v, d, ln)   shfl_src((v), (ln) >= (d) ? (ln) - (d) : (ln))
#define SHFL_DOWN(v, d, ln) shfl_src((v), (ln) + (d) < 64 ? (ln) + (d) : (ln))
__device__ __forceinline__ float wave_sum(float v, int lane) {
#pragma unroll
    for (int o = 1; o < 64; o <<= 1) v += SHFL_XOR(v, o, lane);
    return v;
}
#define LDS_WAIT() asm volatile("s_waitcnt lgkmcnt(0)" ::: "memory")

namespace pg8 {
#define PG8_LAS __attribute__((address_space(3)))
typedef unsigned short bf16_t;
constexpr int BM = 256, BK = 64, HALF = 128, HTB = HALF * BK * 2, STAGE_BYTES = 8 * HTB, NXCD = 8, WGM = 8;
__host__ __device__ __forceinline__ int lds_byte(int r, int c) { const int st = (r >> 4) * 2 + (c >> 5), rr = r & 15, cc = c & 31, ob = rr * 64 + cc * 2; return st * 1024 + (ob ^ (((ob >> 9) & 1) << 5)); }
__host__ __device__ __forceinline__ void stage_rc(int b, int& R, int& C) { const int st = b / 1024, sb = b % 1024, swz = sb ^ (((sb >> 9) & 1) << 5); R = (st >> 1) * 16 + swz / 64; C = (st & 1) * 32 + (swz % 64) / 2; }
__host__ __device__ __forceinline__ int perm32(int rho) { const int n = rho >> 4, i = rho & 15; return 8 * (i >> 2) + 4 * n + (i & 3); }
struct Unit { int pm, pn, k0, nk, role, r, part; };
constexpr int U_PUB = 1, U_OWN = 2, U_FIRST = 4, U_LAST = 8;
struct Gemm { const GAS bf16_t* A; const GAS bf16_t* Bt; int M, N, K; };
template <int NM, int NN, int NT> struct StreamOrder {
    static constexpr int nwg = NM * NN;
    int G, c, nfull, R, s, ls, own;
    __device__ __forceinline__ void init(int G_, int c_, int nslab, int own_ = 0) { G = G_; c = c_; nfull = nwg / G; R = nwg % G; s = 1; ls = 0; own = own_;
        if (R > 0 && (G % 8) == 0 && (R % 8) == 0 && G == (nslab + 1) * R) { if (G == 2 * R && NT % 4 == 0 && NT / 2 >= 4) { s = 2; ls = 1; } else if (G == 4 * R && NT % 8 == 0 && NT / 4 >= 4) { s = 4; ls = 2; } } }
    __device__ __forceinline__ void tile_of(int L, Unit& u) const {
        int wgid = L; { constexpr int q = nwg / NXCD, r = nwg % NXCD; const int xcd = wgid % NXCD, off = wgid / NXCD; wgid = (xcd < r ? xcd * (q + 1) : r * (q + 1) + (xcd - r) * q) + off; }
        constexpr int nig = WGM * NN; static_assert(NM % WGM == 0, "row groups of 8");
        const int gid = wgid / nig, fm = gid * WGM, rem = wgid % nig;
        u.pm = fm + (rem % WGM); u.pn = rem / WGM; }
    __device__ __forceinline__ bool next(int i, Unit& u) const {
        u.k0 = 0; u.nk = NT; u.role = U_FIRST | U_LAST; u.r = 0; u.part = 0;
        if (i < nfull) { tile_of(i * G + c, u); return true; }
        if (i > nfull || R == 0) return false;
        if (s == 1) { if (c >= R) return false; tile_of(nfull * G + c, u); return true; }
        const int j = c >> 3, xcd = c & 7; u.r = xcd + 8 * (j >> ls); u.part = j & (s - 1);
        tile_of(nfull * G + u.r, u); u.nk = NT >> ls; u.k0 = u.part * u.nk; u.role = ((own && u.part == s - 1) ? U_OWN : U_PUB) | U_FIRST | U_LAST; return true;
    }
    __device__ __forceinline__ void a_ready(const Unit&) const {}
    __device__ __forceinline__ void done(const Unit&) const {}
};
template <int NM, int NN, int NT> struct TailOrder : StreamOrder<NM, NN, NT> {
    int heavy, bal;
    __device__ __forceinline__ void init(int G_, int c_, int heavy_) { StreamOrder<NM, NN, NT>::init(G_, c_, 0); heavy = heavy_; const int light = G_ - heavy_;
        bal = (this->R > 0 && light > 0 && (G_ % 8) == 0 && (heavy_ % 8) == 0 && this->R % light == 0) ? this->R / light : 0; }
    __device__ __forceinline__ bool next(int i, Unit& u) const {
        u.k0 = 0; u.nk = NT; u.role = U_FIRST | U_LAST; u.r = 0; u.part = 0;
        if (i < this->nfull) { this->tile_of(i * this->G + this->c, u); return true; }
        if (bal == 0) { if (i > this->nfull || this->c >= this->R) return false; this->tile_of(this->nfull * this->G + this->c, u); return true; }
        const int j = i - this->nfull; if (this->c < heavy || j >= bal) return false;
        this->tile_of(this->nfull * this->G + j * (this->G - heavy) + (this->c - heavy), u); return true;
    }
};
struct MergeOrder {
    int G, c, nfull, R, s;
    __device__ __forceinline__ void init(int G_, int c_) { G = G_; c = c_; nfull = 384 / G; R = 384 % G; s = (R > 0 && (G % 8) == 0 && (R % 8) == 0 && G == 2 * R) ? 2 : 1; }
    __device__ __forceinline__ bool next(int i, Unit& u) const {
        u.k0 = 0; u.nk = 32; u.r = 0; u.part = 0;
        int ti, br;
        if (i < 3 * nfull) { ti = c + (i / 3) * G; br = i % 3; u.role = (br == 0 ? U_FIRST : 0) | (br == 2 ? U_LAST : 0); }
        else { const int i2 = i - 3 * nfull; if (R == 0) return false;
            if (s == 1) { if (c >= R || i2 >= 3) return false; ti = nfull * G + c; br = i2; u.role = (br == 0 ? U_FIRST : 0) | (br == 2 ? U_LAST : 0); }
            else { if (i2 >= 2) return false; const int j = c >> 3, xcd = c & 7; u.r = xcd + 8 * (j >> 1); u.part = j & 1; ti = nfull * G + u.r;
                if (u.part == 0) { br = i2; u.role = U_PUB | (i2 == 0 ? U_FIRST : U_LAST); if (i2 == 1) u.nk = 16; }
                else { br = 1 + i2; u.role = U_OWN | (i2 == 0 ? U_FIRST : U_LAST); if (i2 == 0) { u.k0 = 16; u.nk = 16; } } } }
        u.pm = br * 24 + (ti % 24); u.pn = br * 16 + (ti / 24); return true;
    }
    __device__ __forceinline__ void a_ready(const Unit&) const {}
    __device__ __forceinline__ void done(const Unit&) const {}
};

typedef int i32x4v __attribute__((ext_vector_type(4)));
typedef int i32x8v __attribute__((ext_vector_type(8)));
template <class Epi, class Sched, bool ALIGN_EPI = false, bool SP2 = false, bool FP8 = false>
__device__ __forceinline__ void gemm_phase(PG8_LAS unsigned char* lds, const Gemm g, const Sched& S, const Epi& E, const int tid) {
    const int wid = __builtin_amdgcn_readfirstlane(tid >> 6), lane = tid & 63, wr = wid >> 2, wc = wid & 3, fr = lane & 15, fq = lane >> 4;
    const int K = g.K;
    unsigned voffA[2], voffB[2];
#pragma unroll
    for (int i = 0; i < 2; ++i) { int R, C; stage_rc(tid * 16 + i * 8192, R, C); const int Rb = Epi::PERM ? ((R & ~31) + perm32(R & 31)) : R;
        voffA[i] = (unsigned)(R * K + C) * 2u; voffB[i] = (unsigned)(Rb * K + C) * 2u; }
    const size_t kstep = (size_t)(BK * 2);
    const size_t hstep = (size_t)HALF * K * 2;
    const size_t tstep = 2 * hstep;
    const unsigned ldsw = (unsigned)wid * 1024u;
    const int aoff = lds_byte(wr * 64 + fr, fq * 8), boff = lds_byte(wc * 32 + fr, fq * 8);
#define PG8_SA(b, h) (((b) * 2 + (h)) * HTB)
#define PG8_SB(b, h) ((4 + (b) * 2 + (h)) * HTB)
#define PG8_STAGE(bufoff, gbase, voff) do { const GAS char* gb_ = (const GAS char*)(gbase); asm volatile("" : "+s"(gb_)); _Pragma("unroll") for (int _i = 0; _i < 2; ++_i) { \
        unsigned vo_ = (voff)[_i]; asm volatile("" : "+v"(vo_)); __builtin_amdgcn_global_load_lds((const GAS unsigned*)(gb_ + vo_), (PG8_LAS unsigned*)(lds + (bufoff) + ldsw + _i * 8192), 16, 0, 0); } } while (0)
#define PG8_LDA(dst, b, h) do { if constexpr (FP8) { _Pragma("unroll") for (int m = 0; m < 4; ++m) { const i32x4v lo_ = *(const PG8_LAS i32x4v*)(lds + PG8_SA(b, h) + aoff + m * 2048), hi_ = *(const PG8_LAS i32x4v*)(lds + PG8_SA(b, h) + aoff + m * 2048 + 1024); dst##8[m] = __builtin_shufflevector(lo_, hi_, 0, 1, 2, 3, 4, 5, 6, 7); } } \
        else { _Pragma("unroll") for (int m = 0; m < 4; ++m) _Pragma("unroll") for (int k = 0; k < 2; ++k) dst[m][k] = *(const PG8_LAS bf16x8*)(lds + PG8_SA(b, h) + aoff + m * 2048 + k * 1024); } } while (0)
#define PG8_LDB(dst, b, h) do { if constexpr (FP8) { _Pragma("unroll") for (int n = 0; n < 2; ++n) { const i32x4v lo_ = *(const PG8_LAS i32x4v*)(lds + PG8_SB(b, h) + boff + n * 2048), hi_ = *(const PG8_LAS i32x4v*)(lds + PG8_SB(b, h) + boff + n * 2048 + 1024); dst##8[n] = __builtin_shufflevector(lo_, hi_, 0, 1, 2, 3, 4, 5, 6, 7); } } \
        else { _Pragma("unroll") for (int n = 0; n < 2; ++n) _Pragma("unroll") for (int k = 0; k < 2; ++k) dst[n][k] = *(const PG8_LAS bf16x8*)(lds + PG8_SB(b, h) + boff + n * 2048 + k * 1024); } } while (0)
#define PG8_MMA(ai, bj, At, Bt) do { __builtin_amdgcn_s_setprio(1); if constexpr (FP8) { _Pragma("unroll") for (int m = 0; m < 4; ++m) _Pragma("unroll") for (int n = 0; n < 2; ++n) \
            acc[ai][bj][m][n] = __builtin_amdgcn_mfma_scale_f32_16x16x128_f8f6f4(Bt##8[n], At##8[m], acc[ai][bj][m][n], 0, 0, 0, 0, 0, 0); } \
        else { _Pragma("unroll") for (int m = 0; m < 4; ++m) _Pragma("unroll") for (int n = 0; n < 2; ++n) _Pragma("unroll") for (int k = 0; k < 2; ++k) \
            acc[ai][bj][m][n] = __builtin_amdgcn_mfma_f32_16x16x32_bf16(Bt[n][k], At[m][k], acc[ai][bj][m][n], 0, 0, 0); } __builtin_amdgcn_s_setprio(0); } while (0)
#define PG8_WAIT_V(n) asm volatile("s_waitcnt vmcnt(" #n ")" ::: "memory")
#define PG8_WAIT_L(n) asm volatile("s_waitcnt lgkmcnt(" #n ")" ::: "memory")
#define PG8_BAR __builtin_amdgcn_s_barrier()
#define PG8_SCHED __builtin_amdgcn_sched_barrier(0)
#define PG8_RELANE unsigned lz_; asm volatile("s_mov_b32 %0, 0" : "=s"(lz_)); int le_ = (int)__builtin_amdgcn_mbcnt_hi(~0u, __builtin_amdgcn_mbcnt_lo(~0u, lz_))
    Unit cur, nxt; int ui = 0;
    if (!S.next(0, cur)) return;
    f32x4 acc[2][2][4][2];
#pragma unroll
    for (int a = 0; a < 2; ++a)
#pragma unroll
        for (int b = 0; b < 2; ++b)
#pragma unroll
            for (int m = 0; m < 4; ++m)
#pragma unroll
                for (int n = 0; n < 2; ++n) acc[a][b][m][n] = (f32x4){0.f, 0.f, 0.f, 0.f};
    bf16x8 At[4][2], B0[2][2], B1[2][2];
    i32x8v At8[4], B08[2], B18[2];
    const GAS char* cA = (const GAS char*)g.A + (size_t)cur.pm * tstep + (size_t)cur.k0 * kstep; const GAS char* cB = (const GAS char*)g.Bt + (size_t)cur.pn * tstep + (size_t)cur.k0 * kstep;
    S.a_ready(cur);
    if constexpr (SP2) {
        PG8_STAGE(PG8_SB(0, 0), cB, voffB); PG8_STAGE(PG8_SB(0, 1), cB + hstep, voffB); PG8_STAGE(PG8_SA(0, 0), cA, voffA); PG8_STAGE(PG8_SA(0, 1), cA + hstep, voffA);
        if (wr == 1) PG8_BAR;
        PG8_WAIT_V(2); PG8_BAR;
        PG8_STAGE(PG8_SB(1, 0), cB + kstep, voffB); PG8_STAGE(PG8_SA(1, 0), cA + kstep, voffA); PG8_STAGE(PG8_SB(1, 1), cB + hstep + kstep, voffB);
        PG8_WAIT_V(6); PG8_BAR;
    } else {
        PG8_STAGE(PG8_SB(0, 0), cB, voffB); PG8_STAGE(PG8_SA(0, 0), cA, voffA); PG8_STAGE(PG8_SB(0, 1), cB + hstep, voffB); PG8_STAGE(PG8_SA(0, 1), cA + hstep, voffA);
        if (wr == 1) PG8_BAR;
        PG8_WAIT_V(4); PG8_BAR;
        PG8_STAGE(PG8_SB(1, 0), cB + kstep, voffB); PG8_STAGE(PG8_SA(1, 0), cA + kstep, voffA); PG8_STAGE(PG8_SB(1, 1), cB + hstep + kstep, voffB);
        PG8_WAIT_V(6); PG8_BAR;
    }
    for (;;) {
        const bool has_next = S.next(ui + 1, nxt);
        const GAS char* nA = has_next ? (const GAS char*)g.A + (size_t)nxt.pm * tstep + (size_t)nxt.k0 * kstep : cA; const GAS char* nB = has_next ? (const GAS char*)g.Bt + (size_t)nxt.pn * tstep + (size_t)nxt.k0 * kstep : cB;
        const int nt = cur.nk;
        for (int t = 0; t < nt; t += 2) {
            const bool last = (t == nt - 2);
            const GAS char* a1 = cA + (size_t)(t + 1) * kstep;
            const GAS char* a2 = last ? nA : cA + (size_t)(t + 2) * kstep; const GAS char* b2 = last ? nB : cB + (size_t)(t + 2) * kstep;
            const GAS char* a3 = a2 + kstep; const GAS char* b3 = b2 + kstep;
            if (last && has_next) S.a_ready(nxt);
            if constexpr (SP2) {
            PG8_LDB(B0, 0, 0); PG8_LDB(B1, 0, 1); PG8_SCHED; PG8_LDA(At, 0, 0); PG8_STAGE(PG8_SA(1, 1), a1 + hstep, voffA);
            PG8_WAIT_V(8); PG8_WAIT_L(0); PG8_BAR; PG8_MMA(0, 0, At, B0); PG8_MMA(0, 1, At, B1); PG8_BAR; PG8_SCHED;
            PG8_LDA(At, 0, 1); PG8_STAGE(PG8_SB(0, 0), b2, voffB); PG8_STAGE(PG8_SB(0, 1), b2 + hstep, voffB); PG8_STAGE(PG8_SA(0, 0), a2, voffA);
            PG8_WAIT_V(8); PG8_WAIT_L(0); PG8_BAR; PG8_MMA(1, 0, At, B0); PG8_MMA(1, 1, At, B1); PG8_BAR; PG8_SCHED;
            PG8_LDB(B0, 1, 0); PG8_LDB(B1, 1, 1); PG8_SCHED; PG8_LDA(At, 1, 0); PG8_STAGE(PG8_SA(0, 1), a2 + hstep, voffA);
            PG8_WAIT_V(8); PG8_WAIT_L(0); PG8_BAR; PG8_MMA(0, 0, At, B0); PG8_MMA(0, 1, At, B1); PG8_BAR; PG8_SCHED;
            PG8_LDA(At, 1, 1); PG8_STAGE(PG8_SB(1, 0), b3, voffB); PG8_STAGE(PG8_SB(1, 1), b3 + hstep, voffB); PG8_STAGE(PG8_SA(1, 0), a3, voffA);
            PG8_WAIT_V(8); PG8_WAIT_L(0); PG8_BAR; PG8_MMA(1, 0, At, B0); PG8_MMA(1, 1, At, B1); PG8_BAR; PG8_SCHED;
            } else {
            PG8_LDB(B0, 0, 0); PG8_SCHED; PG8_LDA(At, 0, 0); PG8_STAGE(PG8_SA(1, 1), a1 + hstep, voffA);
            PG8_WAIT_L(8); PG8_BAR; PG8_WAIT_L(0); PG8_MMA(0, 0, At, B0); PG8_BAR; PG8_SCHED;
            PG8_LDB(B1, 0, 1); PG8_STAGE(PG8_SB(0, 0), b2, voffB);
            PG8_BAR; PG8_WAIT_L(0); PG8_MMA(0, 1, At, B1); PG8_BAR;
            PG8_LDA(At, 0, 1); PG8_STAGE(PG8_SA(0, 0), a2, voffA);
            PG8_BAR; PG8_WAIT_L(0); PG8_MMA(1, 0, At, B0); PG8_BAR; PG8_SCHED;
            PG8_STAGE(PG8_SB(0, 1), b2 + hstep, voffB);
            PG8_WAIT_V(6); PG8_BAR; PG8_MMA(1, 1, At, B1); PG8_BAR;
            PG8_LDB(B0, 1, 0); PG8_SCHED; PG8_LDA(At, 1, 0); PG8_STAGE(PG8_SA(0, 1), a2 + hstep, voffA);
            PG8_WAIT_L(8); PG8_BAR; PG8_WAIT_L(0); PG8_MMA(0, 0, At, B0); PG8_BAR; PG8_SCHED;
            PG8_LDB(B1, 1, 1); PG8_STAGE(PG8_SB(1, 0), b3, voffB);
            PG8_BAR; PG8_WAIT_L(0); PG8_MMA(0, 1, At, B1); PG8_BAR;
            PG8_LDA(At, 1, 1); PG8_STAGE(PG8_SA(1, 0), a3, voffA);
            PG8_BAR; PG8_WAIT_L(0); PG8_MMA(1, 0, At, B0); PG8_BAR; PG8_SCHED;
            PG8_STAGE(PG8_SB(1, 1), b3 + hstep, voffB);
            PG8_WAIT_V(6); PG8_BAR; PG8_MMA(1, 1, At, B1); PG8_BAR;
            }
        }
        if constexpr (ALIGN_EPI) { if (wr == 0) PG8_BAR; }
        if (!has_next) break;
        { PG8_RELANE; E(acc, cur, wr, wc, le_ & 15, le_ >> 4, wid, le_); } S.done(cur);
        if constexpr (!Epi::ACC_CHAIN) {
#pragma unroll
        for (int a = 0; a < 2; ++a)
#pragma unroll
            for (int b = 0; b < 2; ++b)
#pragma unroll
                for (int m = 0; m < 4; ++m)
#pragma unroll
                    for (int n = 0; n < 2; ++n) acc[a][b][m][n] = (f32x4){0.f, 0.f, 0.f, 0.f};
        }
        cur = nxt; cA = nA; cB = nB; ++ui;
        if constexpr (ALIGN_EPI) { if (wr == 1) PG8_BAR; }
    }
    { PG8_RELANE; E.last(acc, cur, wr, wc, le_ & 15, le_ >> 4, wid, le_); } S.done(cur);
    PG8_WAIT_V(0);
    if constexpr (!ALIGN_EPI) { if (wr == 0) PG8_BAR; }
    PG8_BAR;
#undef PG8_SA
#undef PG8_SB
#undef PG8_STAGE
#undef PG8_LDA
#undef PG8_LDB
#undef PG8_MMA
#undef PG8_WAIT_V
#undef PG8_WAIT_L
#undef PG8_BAR
#undef PG8_SCHED
#undef PG8_RELANE
}
}

#define XB_TMO      128
#define XB_XCNT(j)  (256  + 64 * (j))
#define XB_XSUB(j)  (1280 + 64 * (j))
#define XB_XGEN(j)  (2304 + 64 * (j))
#define XB_TOP      3328
#define XB_TOPGEN   3392
#define XCD_BAR_WORDS 3456
#define XB_SPIN_CAP (1u << 18)
__device__ __forceinline__ unsigned xb_ld(unsigned* p)              { return __hip_atomic_load(p, __ATOMIC_RELAXED, __HIP_MEMORY_SCOPE_AGENT); }
__device__ __forceinline__ unsigned xb_add(unsigned* p, unsigned v) { return __hip_atomic_fetch_add(p, v, __ATOMIC_RELAXED, __HIP_MEMORY_SCOPE_AGENT); }
__device__ __forceinline__ unsigned xb_xcc_id() { return (unsigned)__builtin_amdgcn_s_getreg((3 << 11) | 20) & 0xFu; }
#define XB_SPIN(cond, bar) do { unsigned _sp = 0; while (cond) { __builtin_amdgcn_s_sleep(1); \
    if ((++_sp & 255u) == 0u) { if (xb_ld(&(bar)[XB_TMO])) break; if (_sp > XB_SPIN_CAP) { atomicAdd(&(bar)[XB_TMO], 1u); break; } } } } while (0)
struct XcdBarrier { unsigned* bar; unsigned x; volatile LAS unsigned* st; };
__device__ __forceinline__ XcdBarrier xcd_barrier_post(unsigned* bar, volatile LAS unsigned* st) {
    XcdBarrier b; b.bar = bar; b.x = xb_xcc_id(); b.st = st;
    if (threadIdx.x == 0) (void)xb_add(&bar[XB_XCNT(b.x)], 1u);
    return b;
}
__device__ __forceinline__ void xcd_barrier_complete(unsigned* bar, unsigned x, unsigned& nloc, unsigned& nx) {
    const unsigned G = gridDim.x * gridDim.y * gridDim.z;
    unsigned sum, cnt, mine, sp = 0u;
    for (;;) {
        sum = 0u; cnt = 0u; mine = 0u;
#pragma unroll
        for (unsigned j = 0; j < 16; ++j) { const unsigned c = xb_ld(&bar[XB_XCNT(j)]); sum += c; cnt += (c > 0u) ? 1u : 0u; mine = (j == x) ? c : mine; }
        if (sum == G) break;
        __builtin_amdgcn_s_sleep(1);
        if ((++sp & 255u) == 0u) { if (xb_ld(&bar[XB_TMO])) break; if (sp > XB_SPIN_CAP) { atomicAdd(&bar[XB_TMO], 1u); break; } }
    }
    nloc = mine > 0u ? mine : 1u; nx = cnt > 0u ? cnt : 1u;
}
__device__ __forceinline__ void xcd_barrier(const XcdBarrier& b) {
    asm volatile("s_waitcnt vmcnt(0)" ::: "memory");
    __syncthreads();
    if (threadIdx.x == 0) {
        unsigned* bar = b.bar;
        __builtin_amdgcn_s_waitcnt(0);
        unsigned nloc = b.st[0], nx = b.st[1];
        if (nloc == 0u) { xcd_barrier_complete(bar, b.x, nloc, nx); b.st[0] = nloc; b.st[1] = nx; }
        const unsigned old = xb_add(&bar[XB_XSUB(b.x)], 1u);
        const unsigned gen = old / nloc;
        if (old + 1u == (gen + 1u) * nloc) {
            __builtin_amdgcn_fence(__ATOMIC_RELEASE, "agent");
            asm volatile("s_waitcnt vmcnt(0)" ::: "memory");
            const unsigned og = xb_add(&bar[XB_TOP], 1u);
            const unsigned tg = og / nx;
            if (og + 1u == (tg + 1u) * nx) xb_add(&bar[XB_TOPGEN], 1u);
            else XB_SPIN(xb_ld(&bar[XB_TOPGEN]) == tg, bar);
            __builtin_amdgcn_fence(__ATOMIC_ACQUIRE, "agent");
            xb_add(&bar[XB_XGEN(b.x)], 1u);
            asm volatile("s_waitcnt vmcnt(0)" ::: "memory");
        } else {
            XB_SPIN(xb_ld(&bar[XB_XGEN(b.x)]) == gen, bar);
            __builtin_amdgcn_fence(__ATOMIC_ACQUIRE, "agent");
            asm volatile("s_waitcnt vmcnt(0)" ::: "memory");
        }
    }
    __syncthreads();
}

struct Args { const float* in[35]; float* out; unsigned char* ws; int ph_lo, ph_hi; };
struct Frame {
    LAS unsigned char* lds; int tid, lane, wave, vcu, G;
    const float* const* in; float* out; unsigned char* ws;
};
#define WSP(T, off) ((GAS T*)(F.ws + (off)))
#define GIN(i) ((const GAS float*)F.in[i])
#define GOUT ((GAS float*)F.out)
__device__ __forceinline__ Frame launder(Frame P) {
    asm volatile("" : "+s"(P.ws), "+s"(P.out), "+s"(P.vcu), "+s"(P.G), "+s"(P.wave));
    unsigned lz; asm volatile("s_mov_b32 %0, 0" : "=s"(lz));
    int ln = (int)__builtin_amdgcn_mbcnt_hi(~0u, __builtin_amdgcn_mbcnt_lo(~0u, lz));
    P.lane = ln; P.tid = P.wave * 64 + ln;
    return P;
}
__device__ __forceinline__ int launder_s(int x) { asm volatile("" : "+s"(x)); return x; }
__device__ __forceinline__ int cond_of_panel(int pm) { return pm < 16 ? 0 : 1 + ((pm - 16) >> 2); }

struct SplitCtx { GAS float* slab; GAS unsigned* cnt; GAS unsigned* tmo; int nslab; };
typedef unsigned v4u_t __attribute__((ext_vector_type(4)));
typedef unsigned v2u_t __attribute__((ext_vector_type(2)));
#define WT_RSRC(p) __builtin_amdgcn_make_buffer_rsrc((void*)(p), (short)0, 0x7FFFFFFF, 0x00020000)
#define WT_ST128(rs, voff, soff, v) __builtin_amdgcn_raw_buffer_store_b128(__builtin_bit_cast(v4u_t, (v)), (rs), (int)(voff), (int)(soff), 16)
#define WT_ST64(rs, voff, soff, v)  __builtin_amdgcn_raw_buffer_store_b64(__builtin_bit_cast(v2u_t, (v)), (rs), (int)(voff), (int)(soff), 16)
#define WT_ST32(rs, voff, soff, v)  __builtin_amdgcn_raw_buffer_store_b32((unsigned)(v), (rs), (int)(voff), (int)(soff), 16)
__device__ __forceinline__ void split_count(const SplitCtx& sx, int r, int lane) {
    asm volatile("s_waitcnt vmcnt(0)" ::: "memory");
    if (lane == 0) __hip_atomic_fetch_add(sx.cnt + 64 * r, 1u, __ATOMIC_RELAXED, __HIP_MEMORY_SCOPE_AGENT);
}
__device__ __forceinline__ void split_wait(const SplitCtx& sx, int r, unsigned need, int wid) {
    if (wid == 0) {
        unsigned sp = 0;
        while ((unsigned)__builtin_amdgcn_readfirstlane((int)__hip_atomic_load(sx.cnt + 64 * r, __ATOMIC_RELAXED, __HIP_MEMORY_SCOPE_AGENT)) < need) {
            __builtin_amdgcn_s_sleep(2);
            if (++sp > (1u << 22)) { __hip_atomic_store(sx.tmo, 1u, __ATOMIC_RELAXED, __HIP_MEMORY_SCOPE_AGENT); break; } }
        __builtin_amdgcn_fence(__ATOMIC_ACQUIRE, "agent");
        asm volatile("s_waitcnt vmcnt(0)" ::: "memory");
    }
    asm volatile("" ::: "memory"); __builtin_amdgcn_s_barrier(); asm volatile("" ::: "memory");
}
__device__ __forceinline__ void split_publish(const SplitCtx& sx, const f32x4 (&acc)[2][2][4][2], const pg8::Unit& u, int wid, int lane) {
    const __amdgpu_buffer_rsrc_t rs = __builtin_amdgcn_make_buffer_rsrc((void*)(sx.slab + (size_t)(u.r * sx.nslab + u.part) * 65536), (short)0, 262144, 0x00020000);
    const int tb = (wid * 64 + lane) * 16;
#pragma unroll
    for (int ai = 0; ai < 2; ++ai)
#pragma unroll
        for (int bj = 0; bj < 2; ++bj)
#pragma unroll
            for (int m = 0; m < 4; ++m)
#pragma unroll
                for (int n = 0; n < 2; ++n) __builtin_amdgcn_raw_buffer_store_b128(__builtin_bit_cast(v4u_t, acc[ai][bj][m][n]), rs, tb, (((ai * 2 + bj) * 4 + m) * 2 + n) * 8192, 16);
    split_count(sx, u.r, lane);
}
template <bool PERM>
__device__ __forceinline__ void split_store(const SplitCtx& sx, const f32x4 (&acc)[2][2][4][2], const pg8::Unit& u, int npart, int wr, int wc, int fr, int fq) {
    GAS float* sl = sx.slab + (size_t)(u.r * npart + u.part) * 65536 + (wr * 64 + fr) * 256 + wc * 32 + (PERM ? 8 : 4) * fq;
#pragma unroll
    for (int ai = 0; ai < 2; ++ai)
#pragma unroll
        for (int m = 0; m < 4; ++m)
#pragma unroll
            for (int bj = 0; bj < 2; ++bj)
#pragma unroll
                for (int n = 0; n < 2; ++n) *(GAS f32x4*)(sl + (ai * 128 + m * 16) * 256 + bj * 128 + (PERM ? 4 : 16) * n) = acc[ai][bj][m][n];
}

struct EpiProj {
    static constexpr bool PERM = true, ACC_CHAIN = false;
    static constexpr int NSLAB = 0;
    GAS bf16* P; const GAS float* bias; SplitCtx sx; int f8;
    __device__ __forceinline__ void last(f32x4 (&acc)[2][2][4][2], const pg8::Unit& u, int wr, int wc, int fr, int fq, int wid, int lane) const { if ((u.role & 3) != 0) { split_store<PERM>(sx, acc, u, NSLAB + 1, wr, wc, fr, fq); return; } (*this)(acc, u, wr, wc, fr, fq, wid, lane); }
    __device__ __forceinline__ void operator()(const f32x4 (&acc)[2][2][4][2], const pg8::Unit& u, int wr, int wc, int fr, int fq, int wid, int lane) const {
        asm volatile("" : "+v"(fr), "+v"(fq), "+v"(lane));
        const int seg = f8 ? seg_of_g(u.pn >> 3) : seg_of_b(u.pn >> 3); const int act = (seg >= 9) ? 2 : ((seg == 1 || seg == 3 || seg == 4 || seg == 8) ? 1 : 0);
        const int row0 = u.pm * 256 + wr * 64 + fr, col0 = (u.pn & 7) * 256 + wc * 32 + 8 * fq, bcol0 = seg * 2048 + col0;
        GAS bf16* base = P + (size_t)seg * SEG_ELEMS; const float asc = f8 ? 1.f / W8_SCALE : 1.f;
        f32x4 bv[2][2];
#pragma unroll
        for (int bj = 0; bj < 2; ++bj)
#pragma unroll
            for (int n = 0; n < 2; ++n) bv[bj][n] = *(const GAS f32x4*)(bias + bcol0 + bj * 128 + 4 * n);
#pragma unroll
        for (int ai = 0; ai < 2; ++ai)
#pragma unroll
            for (int m = 0; m < 4; ++m) { GAS bf16* rowp = base + (size_t)(row0 + ai * 128 + m * 16) * WB + col0;
#pragma unroll
                for (int bj = 0; bj < 2; ++bj) { f32x4 v0 = acc[ai][bj][m][0] * asc + bv[bj][0], v1 = acc[ai][bj][m][1] * asc + bv[bj][1];
                    if (act == 1) {
#pragma unroll
                        for (int j = 0; j < 4; ++j) { v0[j] = siluf(v0[j]); v1[j] = siluf(v1[j]); } }
                    else if (act == 2) {
#pragma unroll
                        for (int j = 0; j < 4; ++j) { v0[j] = sigm(v0[j]); v1[j] = sigm(v1[j]); } }
                    u32x4 w; w.x = cvt_pk_bf16(v0[0], v0[1]); w.y = cvt_pk_bf16(v0[2], v0[3]); w.z = cvt_pk_bf16(v1[0], v1[1]); w.w = cvt_pk_bf16(v1[2], v1[3]);
                    *(GAS u32x4*)(rowp + bj * 128) = w; } }
    }
};
struct EpiGlu {
    static constexpr bool PERM = true, ACC_CHAIN = false;
    static constexpr int NSLAB = 0;
    const GAS bf16* YAP; const GAS bf16* GA; GAS bf16* YA; const GAS float* bias; SplitCtx sx;
    __device__ __forceinline__ void last(f32x4 (&acc)[2][2][4][2], const pg8::Unit& u, int wr, int wc, int fr, int fq, int wid, int lane) const { (*this)(acc, u, wr, wc, fr, fq, wid, lane); }
    __device__ __forceinline__ void operator()(const f32x4 (&acc)[2][2][4][2], const pg8::Unit& u, int wr, int wc, int fr, int fq, int wid, int lane) const {
        asm volatile("" : "+v"(fr), "+v"(fq), "+v"(lane));
        const int row0 = u.pm * 256 + wr * 64 + fr, col0 = u.pn * 256 + wc * 32 + 8 * fq;
        f32x4 bv[2][2];
#pragma unroll
        for (int bj = 0; bj < 2; ++bj)
#pragma unroll
            for (int n = 0; n < 2; ++n) bv[bj][n] = *(const GAS f32x4*)(bias + col0 + bj * 128 + 4 * n);
#pragma unroll
        for (int ai = 0; ai < 2; ++ai)
#pragma unroll
            for (int m = 0; m < 4; ++m) { const size_t ro = (size_t)(row0 + ai * 128 + m * 16) * WB + col0;
#pragma unroll
                for (int bj = 0; bj < 2; ++bj) { const f32x4 v0 = acc[ai][bj][m][0] * (1.f / W8_SCALE) + bv[bj][0], v1 = acc[ai][bj][m][1] * (1.f / W8_SCALE) + bv[bj][1];
                    const u32x4 yv = *(const GAS u32x4*)(YAP + ro + bj * 128), gv = *(const GAS u32x4*)(GA + ro + bj * 128);
                    float o[8];
                    o[0] = bflo(yv.x) * sigm(v0[0]) * bflo(gv.x); o[1] = bfhi(yv.x) * sigm(v0[1]) * bfhi(gv.x);
                    o[2] = bflo(yv.y) * sigm(v0[2]) * bflo(gv.y); o[3] = bfhi(yv.y) * sigm(v0[3]) * bfhi(gv.y);
                    o[4] = bflo(yv.z) * sigm(v1[0]) * bflo(gv.z); o[5] = bfhi(yv.z) * sigm(v1[1]) * bfhi(gv.z);
                    o[6] = bflo(yv.w) * sigm(v1[2]) * bflo(gv.w); o[7] = bfhi(yv.w) * sigm(v1[3]) * bfhi(gv.w);
                    u32x4 w; w.x = cvt_pk_bf16(o[0], o[1]); w.y = cvt_pk_bf16(o[2], o[3]); w.z = cvt_pk_bf16(o[4], o[5]); w.w = cvt_pk_bf16(o[6], o[7]);
                    *(GAS u32x4*)(YA + ro + bj * 128) = w; } }
    }
};
struct EpiMerge {
    static constexpr bool PERM = true, ACC_CHAIN = true;
    const GAS bf16* PROJ; GAS bf16* MG; SplitCtx sx;
    __device__ __forceinline__ void last(f32x4 (&acc)[2][2][4][2], const pg8::Unit& u, int wr, int wc, int fr, int fq, int wid, int lane) const { (*this)(acc, u, wr, wc, fr, fq, wid, lane); }
    __device__ __forceinline__ void operator()(f32x4 (&acc)[2][2][4][2], const pg8::Unit& u, int wr, int wc, int fr, int fq, int wid, int lane) const {
        asm volatile("" : "+v"(fr), "+v"(fq), "+v"(lane));
        const int br = u.pm / 24, pm = u.pm - br * 24, pn = u.pn - br * 16;
        const int role = u.role & 3; const bool last = (u.role & pg8::U_LAST) != 0;
        const int lrow0 = wr * 64 + fr, lcol0 = wc * 32 + 8 * fq;
        const int row0 = pm * 256 + lrow0, col0 = pn * 256 + lcol0;
        const GAS bf16* sg = PROJ + (size_t)(9 + 2 * br + (col0 >> 11)) * SEG_ELEMS + (col0 & 2047);
        const GAS bf16* sn = sg + (last ? 0 : 2) * SEG_ELEMS;
        const __amdgpu_buffer_rsrc_t rs = __builtin_amdgcn_make_buffer_rsrc((void*)(sx.slab + (size_t)u.r * 65536), (short)0, 262144, 0x00020000);
        if (role == pg8::U_OWN && last) split_wait(sx, u.r, 8u, wid);
        const int so_v = (lrow0 * 256 + lcol0) * 4;
        if (!last) {
#pragma unroll
            for (int ai = 0; ai < 2; ++ai)
#pragma unroll
                for (int m = 0; m < 4; ++m) { const int row = row0 + ai * 128 + m * 16;
#pragma unroll
                    for (int bj = 0; bj < 2; ++bj) {
                        const u32x4 sv = *(const GAS u32x4*)(sg + (size_t)row * WB + bj * 128), nv = *(const GAS u32x4*)(sn + (size_t)row * WB + bj * 128);
                        f32x4 d0 = {bflo(nv.x), bfhi(nv.x), bflo(nv.y), bfhi(nv.y)}, d1 = {bflo(nv.z), bfhi(nv.z), bflo(nv.w), bfhi(nv.w)};
                        const f32x4 g0 = {bflo(sv.x), bfhi(sv.x), bflo(sv.y), bfhi(sv.y)}, g1 = {bflo(sv.z), bfhi(sv.z), bflo(sv.w), bfhi(sv.w)};
#pragma unroll
                        for (int e = 0; e < 4; ++e) { d0[e] = g0[e] * frcp(fmaxf(d0[e], 1e-12f)); d1[e] = g1[e] * frcp(fmaxf(d1[e], 1e-12f)); }
                        acc[ai][bj][m][0] *= d0; acc[ai][bj][m][1] *= d1; } }
        } else {
#pragma unroll
            for (int ai = 0; ai < 2; ++ai)
#pragma unroll
                for (int m = 0; m < 4; ++m) { const int lr = ai * 128 + m * 16; const int row = row0 + lr;
#pragma unroll
                    for (int bj = 0; bj < 2; ++bj) {
                        const u32x4 sv = *(const GAS u32x4*)(sg + (size_t)row * WB + bj * 128);
                        const f32x4 g0 = {bflo(sv.x), bfhi(sv.x), bflo(sv.y), bfhi(sv.y)}, g1 = {bflo(sv.z), bfhi(sv.z), bflo(sv.w), bfhi(sv.w)};
                        const int so_s = (lr * 256 + bj * 128) * 4;
                        f32x4 v0 = acc[ai][bj][m][0] * g0, v1 = acc[ai][bj][m][1] * g1;
                        if (role == pg8::U_PUB) { __builtin_amdgcn_raw_buffer_store_b128(__builtin_bit_cast(v4u_t, v0), rs, so_v, so_s, 16); __builtin_amdgcn_raw_buffer_store_b128(__builtin_bit_cast(v4u_t, v1), rs, so_v, so_s + 16, 16); }
                        else { if (role == pg8::U_OWN) { v0 += __builtin_bit_cast(f32x4, __builtin_amdgcn_raw_buffer_load_b128(rs, so_v, so_s, 16)); v1 += __builtin_bit_cast(f32x4, __builtin_amdgcn_raw_buffer_load_b128(rs, so_v, so_s + 16, 16)); }
                            u32x4 w; w.x = cvt_pk_bf16(v0[0], v0[1]); w.y = cvt_pk_bf16(v0[2], v0[3]); w.z = cvt_pk_bf16(v1[0], v1[1]); w.w = cvt_pk_bf16(v1[2], v1[3]);
                            *(GAS u32x4*)(MG + (size_t)row * D + col0 + bj * 128) = w; }
                        acc[ai][bj][m][0] = (f32x4){0.f, 0.f, 0.f, 0.f}; acc[ai][bj][m][1] = (f32x4){0.f, 0.f, 0.f, 0.f}; } }
        }
        if (role == pg8::U_PUB && last) split_count(sx, u.r, lane);
    }
};
struct EpiOut {
    static constexpr bool PERM = true, ACC_CHAIN = false;
    static constexpr int NSLAB = 1;
    const GAS float* bias; const GAS float* mod; GAS bf16* U; SplitCtx sx;
    __device__ __forceinline__ void last(f32x4 (&acc)[2][2][4][2], const pg8::Unit& u, int wr, int wc, int fr, int fq, int wid, int lane) const {
        const int role = u.role & 3;
        if (role == 0) { (*this)(acc, u, wr, wc, fr, fq, wid, lane); return; }
        asm volatile("" : "+v"(fr), "+v"(fq), "+v"(lane));
        const int lrow0 = wr * 64 + fr, lcol0 = wc * 32 + 8 * fq, so_v = (lrow0 * 256 + lcol0) * 4;
        const __amdgpu_buffer_rsrc_t rs = __builtin_amdgcn_make_buffer_rsrc((void*)(sx.slab + (size_t)u.r * 65536), (short)0, 262144, 0x00020000);
        if (role == pg8::U_PUB) {
#pragma unroll
            for (int ai = 0; ai < 2; ++ai)
#pragma unroll
                for (int m = 0; m < 4; ++m)
#pragma unroll
                    for (int bj = 0; bj < 2; ++bj) { const int so_s = ((ai * 128 + m * 16) * 256 + bj * 128) * 4;
                        __builtin_amdgcn_raw_buffer_store_b128(__builtin_bit_cast(v4u_t, acc[ai][bj][m][0]), rs, so_v, so_s, 16); __builtin_amdgcn_raw_buffer_store_b128(__builtin_bit_cast(v4u_t, acc[ai][bj][m][1]), rs, so_v, so_s + 16, 16); }
            split_count(sx, u.r, lane); return; }
        split_wait(sx, u.r, 8u, wid);
        const int row0 = u.pm * 256 + lrow0, col0 = u.pn * 256 + lcol0;
        const GAS float* gate = mod + (size_t)cond_of_panel(u.pm) * 12288 + 8192;
        f32x4 bv[2][2], gv[2][2];
#pragma unroll
        for (int bj = 0; bj < 2; ++bj)
#pragma unroll
            for (int n = 0; n < 2; ++n) { bv[bj][n] = *(const GAS f32x4*)(bias + col0 + bj * 128 + 4 * n); gv[bj][n] = *(const GAS f32x4*)(gate + col0 + bj * 128 + 4 * n); }
#pragma unroll
        for (int ai = 0; ai < 2; ++ai)
#pragma unroll
            for (int m = 0; m < 4; ++m) { GAS bf16* rowp = U + (size_t)(row0 + ai * 128 + m * 16) * D + col0;
#pragma unroll
                for (int bj = 0; bj < 2; ++bj) { const int so_s = ((ai * 128 + m * 16) * 256 + bj * 128) * 4;
                    const f32x4 p0 = __builtin_bit_cast(f32x4, __builtin_amdgcn_raw_buffer_load_b128(rs, so_v, so_s, 16)), p1 = __builtin_bit_cast(f32x4, __builtin_amdgcn_raw_buffer_load_b128(rs, so_v, so_s + 16, 16));
                    const f32x4 v0 = gv[bj][0] * (acc[ai][bj][m][0] + p0 + bv[bj][0]), v1 = gv[bj][1] * (acc[ai][bj][m][1] + p1 + bv[bj][1]);
                    u32x4 w; w.x = cvt_pk_bf16(v0[0], v0[1]); w.y = cvt_pk_bf16(v0[2], v0[3]); w.z = cvt_pk_bf16(v1[0], v1[1]); w.w = cvt_pk_bf16(v1[2], v1[3]);
                    *(GAS u32x4*)(rowp + bj * 128) = w; } }
    }
    __device__ __forceinline__ void operator()(const f32x4 (&acc)[2][2][4][2], const pg8::Unit& u, int wr, int wc, int fr, int fq, int wid, int lane) const {
        asm volatile("" : "+v"(fr), "+v"(fq), "+v"(lane));
        const int row0 = u.pm * 256 + wr * 64 + fr, col0 = u.pn * 256 + wc * 32 + 8 * fq;
        const GAS float* gate = mod + (size_t)cond_of_panel(u.pm) * 12288 + 8192;
        f32x4 bv[2][2], gv[2][2];
#pragma unroll
        for (int bj = 0; bj < 2; ++bj)
#pragma unroll
            for (int n = 0; n < 2; ++n) { bv[bj][n] = *(const GAS f32x4*)(bias + col0 + bj * 128 + 4 * n); gv[bj][n] = *(const GAS f32x4*)(gate + col0 + bj * 128 + 4 * n); }
#pragma unroll
        for (int ai = 0; ai < 2; ++ai)
#pragma unroll
            for (int m = 0; m < 4; ++m) { GAS bf16* rowp = U + (size_t)(row0 + ai * 128 + m * 16) * D + col0;
#pragma unroll
                for (int bj = 0; bj < 2; ++bj) { const f32x4 v0 = gv[bj][0] * (acc[ai][bj][m][0] + bv[bj][0]), v1 = gv[bj][1] * (acc[ai][bj][m][1] + bv[bj][1]);
                    u32x4 w; w.x = cvt_pk_bf16(v0[0], v0[1]); w.y = cvt_pk_bf16(v0[2], v0[3]); w.z = cvt_pk_bf16(v1[0], v1[1]); w.w = cvt_pk_bf16(v1[2], v1[3]);
                    *(GAS u32x4*)(rowp + bj * 128) = w; } }
    }
};

struct P0Item { const GAS float* W; GAS bf16* WT; int K, N, item, win; };
__device__ __forceinline__ void p0_load(const P0Item& d, float (&rg)[32], int lane) {
    const int nblk = d.N / 32, kb = d.item / nblk, nb = d.item % nblk, k0 = 64 * kb, n0 = 32 * nb;
    const GAS float* p = d.W + (size_t)(k0 + (lane >> 5)) * d.N + n0 + (lane & 31);
#pragma unroll
    for (int i = 0; i < 32; ++i) rg[i] = __builtin_nontemporal_load(p + (size_t)(2 * i) * d.N);
}
__device__ __forceinline__ void p0_finish(const P0Item& d, const float (&rg)[32], LAS float* scr, int lane) {
    const int nblk = d.N / 32, kb = d.item / nblk, nb = d.item % nblk, k0 = 64 * kb, n0 = 32 * nb;
#pragma unroll
    for (int i = 0; i < 32; ++i) scr[(2 * i + (lane >> 5)) * 33 + (lane & 31)] = rg[i];
    LDS_WAIT(); asm volatile("" ::: "memory");
    const int c = lane & 7;
    const int seg = n0 >> 11; const bool f8 = (d.win == 1 && seg_is_fp8(seg)) || d.win == 2;
    const int rbase = d.win == 1 ? seg_local(seg) * 2048 + (n0 & 2047) : n0;
#pragma unroll
    for (int j = 0; j < 4; ++j) { const int n = (lane >> 3) + 8 * j; const LAS float* s = scr + (8 * c) * 33 + n;
        if (!f8) { u32x4 o; o.x = cvt_pk_bf16(s[0 * 33], s[1 * 33]); o.y = cvt_pk_bf16(s[2 * 33], s[3 * 33]); o.z = cvt_pk_bf16(s[4 * 33], s[5 * 33]); o.w = cvt_pk_bf16(s[6 * 33], s[7 * 33]);
            *(GAS u32x4*)(d.WT + (size_t)(rbase + n) * d.K + k0 + 8 * c) = o; }
        else { int w0 = 0, w1 = 0;
#define P0_F8(i) __builtin_amdgcn_fmed3f(s[(i) * 33] * W8_SCALE, -448.f, 448.f)
            w0 = __builtin_amdgcn_cvt_pk_fp8_f32(P0_F8(0), P0_F8(1), w0, false); w0 = __builtin_amdgcn_cvt_pk_fp8_f32(P0_F8(2), P0_F8(3), w0, true);
            w1 = __builtin_amdgcn_cvt_pk_fp8_f32(P0_F8(4), P0_F8(5), w1, false); w1 = __builtin_amdgcn_cvt_pk_fp8_f32(P0_F8(6), P0_F8(7), w1, true);
#undef P0_F8
            u32x2 o; o.x = (unsigned)w0; o.y = (unsigned)w1;
            *(GAS u32x2*)((GAS unsigned char*)d.WT + (d.win == 1 ? 144 * MiB : 0) + (size_t)(rbase + n) * d.K + k0 + 8 * c) = o; } }
    LDS_WAIT(); asm volatile("" ::: "memory");
}
constexpr int P0_I_IN = 64 * 960, P0_I_GLU = 32 * 64, P0_I_BR = 32 * 128, P0_I_OUT = 64 * 128, P0_I_LRU = 8;
constexpr int P0_PER_LAYER = P0_I_IN + P0_I_GLU + 3 * P0_I_BR + P0_I_OUT + 64 * P0_I_LRU;
__device__ __forceinline__ P0Item p0_desc(const Frame& F, int it) {
    const int l = it / P0_PER_LAYER; int r = it - l * P0_PER_LAYER;
    if (r < P0_I_IN) return P0Item{GIN(9) + (size_t)l * D * INC, WSP(bf16, WS_WIN) + (size_t)l * INC * D, D, INC, r, 1}; r -= P0_I_IN;
    if (r < P0_I_GLU) return P0Item{GIN(19) + (size_t)l * WB * WB, WSP(bf16, WS_WGLU) + (size_t)l * WB * WB, WB, WB, r, 2}; r -= P0_I_GLU;
    if (r < 3 * P0_I_BR) { const int b = r / P0_I_BR; return P0Item{GIN(30) + (size_t)(l * 3 + b) * WB * D, WSP(bf16, WS_WBR) + (size_t)(l * 3 + b) * D * WB, WB, D, r - b * P0_I_BR, 0}; } r -= 3 * P0_I_BR;
    if (r < P0_I_OUT) return P0Item{GIN(31) + (size_t)l * D * D, WSP(bf16, WS_WOUT) + (size_t)l * D * D, D, D, r, 0}; r -= P0_I_OUT;
    const int mi = r / P0_I_LRU, sub = r - mi * P0_I_LRU;
    const int dr = mi >> 5, mat = (mi >> 4) & 1, n = mi & 15;
    return P0Item{(mat ? GIN(25) : GIN(23)) + (size_t)((l * 2 + dr) * 16 + n) * 16384, WSP(bf16, WS_WLRU) + (size_t)(l * 64 + mi) * 16384, 128, 128, sub, 0};
}
__device__ __forceinline__ void p0_prologue(const Frame& F) {
    if (F.vcu < 96) {
        const int l = F.vcu / 48, j0 = (F.vcu % 48) * 256;
        LAS float* sc = (LAS float*)F.lds;
        LAS float* red = (LAS float*)(F.lds + 49152);
        for (int i = F.tid; i < 3 * 4096; i += 512) { const int c = i >> 12, k = i & 4095; const float v = c == 0 ? GIN(6)[k] : GIN(5)[(c - 1) * 4096 + k]; sc[i] = siluf(v); }
        __syncthreads();
        const GAS float* W = GIN(7) + (size_t)l * 4096 * 12288 + j0 + 4 * F.lane;
        f32x4 a0 = {0.f, 0.f, 0.f, 0.f}, a1 = a0, a2 = a0;
        const int i0 = F.wave * 512;
#pragma unroll 8
        for (int i = i0; i < i0 + 512; ++i) { const f32x4 w = *(const GAS f32x4*)(W + (size_t)i * 12288); a0 += sc[i] * w; a1 += sc[4096 + i] * w; a2 += sc[8192 + i] * w; }
        *(LAS f32x4*)(red + (F.wave * 3 + 0) * 256 + 4 * F.lane) = a0; *(LAS f32x4*)(red + (F.wave * 3 + 1) * 256 + 4 * F.lane) = a1; *(LAS f32x4*)(red + (F.wave * 3 + 2) * 256 + 4 * F.lane) = a2;
        __syncthreads();
        for (int o = F.tid; o < 768; o += 512) { const int c = o >> 8, j = o & 255; float s = GIN(8)[l * 12288 + j0 + j];
#pragma unroll
            for (int w = 0; w < 8; ++w) s += red[(w * 3 + c) * 256 + j];
            WSP(float, WS_MOD)[(l * 3 + c) * 12288 + j0 + j] = s; }
        __syncthreads();
    }
    LAS float* scr = (LAS float*)(F.lds + F.wave * 16384);
    const int gw = F.vcu * 8 + F.wave, NGW = F.G * 8;
    constexpr int T = 2 * P0_PER_LAYER, P0_SKIP = 6; const int GVW = 96 * 8;
    const int NR = NGW > GVW ? (T / NGW > P0_SKIP ? T / NGW - P0_SKIP : 0) : T / NGW + 1;
#define P0_ITEM_AT(k) ((k) < NR ? gw + (k) * NGW : (gw < GVW ? T : NR * NGW + (gw - GVW) + ((k) - NR) * (NGW - GVW)))
    if (P0_ITEM_AT(0) < T) {
        P0Item cur = p0_desc(F, P0_ITEM_AT(0)); float rc[32]; p0_load(cur, rc, F.lane);
        for (int k = 0; P0_ITEM_AT(k) < T; ++k) {
            const int itn = P0_ITEM_AT(k + 1); const bool has = itn < T;
            P0Item nxt = cur; float rn[32];
            if (has) { nxt = p0_desc(F, itn); p0_load(nxt, rn, F.lane); }
            else {
#pragma unroll
                for (int i = 0; i < 32; ++i) rn[i] = 0.f; }
            p0_finish(cur, rc, scr, F.lane);
            cur = nxt;
#pragma unroll
            for (int i = 0; i < 32; ++i) rc[i] = rn[i];
        }
    }
#undef P0_ITEM_AT
    __syncthreads();
}

template <int MODE>
__device__ __forceinline__ void ln_phase(const Frame& F, int l) {
    const int gw = F.vcu * 8 + F.wave, NGW = F.G * 8;
    const GAS float* modl = WSP(float, WS_MOD) + (size_t)l * 3 * 12288;
    for (int m = gw; m < NTOK; m += NGW) {
        const GAS float* src = (m < NCTX ? GIN(0) + (size_t)m * D : GIN(1) + (size_t)(m - NCTX) * D);
        GAS bf16* x1row = WSP(bf16, WS_X1) + (size_t)m * D;
        const GAS bf16* usrc = WSP(bf16, WS_V) + (size_t)m * D;
        f32x4 v[16]; float s = 0.f;
#pragma unroll
        for (int j = 0; j < 16; ++j) {
            if (MODE == 2) { const u32x2 xw = *(const GAS u32x2*)(x1row + 256 * j + 4 * F.lane); v[j] = (f32x4){bflo(xw.x), bfhi(xw.x), bflo(xw.y), bfhi(xw.y)}; }
            else v[j] = *(const GAS f32x4*)(src + 256 * j + 4 * F.lane);
            if (MODE != 0) { const u32x2 uw = *(const GAS u32x2*)(usrc + 256 * j + 4 * F.lane); v[j] = DN_ALPHA * v[j] + (f32x4){bflo(uw.x), bfhi(uw.x), bflo(uw.y), bfhi(uw.y)}; }
            s += (v[j][0] + v[j][1]) + (v[j][2] + v[j][3]); }
        float mean = wave_sum(s, F.lane) * (1.f / D), s2 = 0.f;
#pragma unroll
        for (int j = 0; j < 16; ++j) { v[j] = v[j] - mean; s2 += (v[j][0] * v[j][0] + v[j][1] * v[j][1]) + (v[j][2] * v[j][2] + v[j][3] * v[j][3]); }
        float rstd = 1.f / sqrtf(wave_sum(s2, F.lane) * (1.f / D) + LN_EPS);
        if (MODE != 0) {
            const GAS float* g = GIN(33) + (size_t)(MODE == 1 ? l - 1 : l) * D; const GAS float* b = GIN(34) + (size_t)(MODE == 1 ? l - 1 : l) * D;
            GAS float* dst = GOUT + (size_t)m * D;
            s = 0.f;
#pragma unroll
            for (int j = 0; j < 16; ++j) { const f32x4 gg = *(const GAS f32x4*)(g + 256 * j + 4 * F.lane), bb = *(const GAS f32x4*)(b + 256 * j + 4 * F.lane);
                v[j] = v[j] * rstd * gg + bb;
                if (MODE == 1) { u32x2 xw; xw.x = cvt_pk_bf16(v[j][0], v[j][1]); xw.y = cvt_pk_bf16(v[j][2], v[j][3]); WT_ST64(WT_RSRC(WSP(bf16, WS_X1)), 8 * F.lane, (m * D + 256 * j) * 2, xw); }
                else *(GAS f32x4*)(dst + 256 * j + 4 * F.lane) = v[j];
                s += (v[j][0] + v[j][1]) + (v[j][2] + v[j][3]); }
            if (MODE == 2) continue;
            mean = wave_sum(s, F.lane) * (1.f / D); s2 = 0.f;
#pragma unroll
            for (int j = 0; j < 16; ++j) { v[j] = v[j] - mean; s2 += (v[j][0] * v[j][0] + v[j][1] * v[j][1]) + (v[j][2] * v[j][2] + v[j][3] * v[j][3]); }
            rstd = 1.f / sqrtf(wave_sum(s2, F.lane) * (1.f / D) + LN_EPS);
        }
        const GAS float* md = modl + (size_t)(m < NCTX ? 0 : 1 + ((m - NCTX) >> 10)) * 12288;
        GAS bf16* hrow = WSP(bf16, WS_H) + (size_t)m * D;
#pragma unroll
        for (int j = 0; j < 16; ++j) { const f32x4 sh = *(const GAS f32x4*)(md + 256 * j + 4 * F.lane), scl = *(const GAS f32x4*)(md + 4096 + 256 * j + 4 * F.lane);
            const f32x4 h = v[j] * rstd * (1.f + scl) + sh; u32x2 w; w.x = cvt_pk_bf16(h[0], h[1]); w.y = cvt_pk_bf16(h[2], h[3]);
            WT_ST64(WT_RSRC(WSP(bf16, WS_H)), 8 * F.lane, (m * D + 256 * j) * 2, w);
            int w8 = 0;
            w8 = __builtin_amdgcn_cvt_pk_fp8_f32(__builtin_amdgcn_fmed3f(h[0], -448.f, 448.f), __builtin_amdgcn_fmed3f(h[1], -448.f, 448.f), w8, false);
            w8 = __builtin_amdgcn_cvt_pk_fp8_f32(__builtin_amdgcn_fmed3f(h[2], -448.f, 448.f), __builtin_amdgcn_fmed3f(h[3], -448.f, 448.f), w8, true);
            WT_ST32(WT_RSRC(WSP(unsigned char, WS_TMP)), 4 * F.lane, m * D + 256 * j, w8); }
    }
}

__device__ __forceinline__ void s5_coef(const GAS float* are, const GAS float* aim, float dt, int p, float& lr, float& li, float& zr, float& zi) {
    const float ar = fminf(are[p], -1e-4f), ai = aim[p];
    const float mag = expf(dt * ar); float sn, cs; sincosf(dt * ai, &sn, &cs);
    lr = mag * cs; li = mag * sn;
    const float den = ar * ar + ai * ai;
    zr = ((lr - 1.f) * ar + li * ai) / den; zi = (li * ar - (lr - 1.f) * ai) / den;
}
__device__ __forceinline__ void s5_item(const Frame& F, int l, int sq, int g, int dr, LAS unsigned char* wl) {
    const int lane = F.lane, r = lane & 15, q = lane >> 4;
    const bool lat = sq >= 16; const int L = lat ? 1024 : 256, mbase = lat ? NCTX + (sq - 16) * 1024 : sq * 256;
    LAS float* XS = (LAS float*)wl;
    LAS bf16* HS = (LAS bf16*)(wl + 8448);
    const GAS float* are = GIN(11) + (size_t)((l * 2 + dr) * 128 + g) * 64; const GAS float* aim = GIN(12) + (size_t)((l * 2 + dr) * 128 + g) * 64;
    const float dt = expf(GIN(13)[(l * 2 + dr) * 128 + g]);
    float lr, li, zr0, zi0; s5_coef(are, aim, dt, lane, lr, li, zr0, zi0);
    bf16x8 bzf[8];
#pragma unroll
    for (int nt = 0; nt < 8; ++nt) {
        const int pp = 8 * nt + (r >> 1); float a_, b_, zr, zi; s5_coef(are, aim, dt, pp, a_, b_, zr, zi);
        u32x4 w = {0u, 0u, 0u, 0u};
        if (q < 2) {
            const GAS float* pbr = GIN(14) + ((size_t)(l * 128 + g) * 64 + pp) * 16 + 8 * q; const GAS float* pbi = GIN(15) + ((size_t)(l * 128 + g) * 64 + pp) * 16 + 8 * q;
            const f32x4 r0 = *(const GAS f32x4*)pbr, r1 = *(const GAS f32x4*)(pbr + 4), i0 = *(const GAS f32x4*)pbi, i1 = *(const GAS f32x4*)(pbi + 4);
            const bool im = (r & 1) != 0;
            const f32x4 x0 = im ? zr * i0 + zi * r0 : zr * r0 - zi * i0, x1 = im ? zr * i1 + zi * r1 : zr * r1 - zi * i1;
            w.x = cvt_pk_bf16(x0[0], x0[1]); w.y = cvt_pk_bf16(x0[2], x0[3]); w.z = cvt_pk_bf16(x1[0], x1[1]); w.w = cvt_pk_bf16(x1[2], x1[3]);
        }
        bzf[nt] = __builtin_bit_cast(bf16x8, w);
    }
    bf16x8 cmf[4];
#pragma unroll
    for (int ks = 0; ks < 4; ++ks) {
        const int p0 = 16 * ks + 4 * q;
        const f32x4 cr = *(const GAS f32x4*)(GIN(16) + ((size_t)(l * 128 + g) * 16 + r) * 64 + p0), ci = *(const GAS f32x4*)(GIN(17) + ((size_t)(l * 128 + g) * 16 + r) * 64 + p0);
        u32x4 w; w.x = cvt_pk_bf16(cr[0], -ci[0]); w.y = cvt_pk_bf16(cr[1], -ci[1]); w.z = cvt_pk_bf16(cr[2], -ci[2]); w.w = cvt_pk_bf16(cr[3], -ci[3]);
        cmf[ks] = __builtin_bit_cast(bf16x8, w);
    }
    float hr = 0.f, hi = 0.f;
    if (lat) { const GAS float* st = GIN(2) + ((size_t)(((sq - 16) * 2 + l) * 2 + dr) * 128 + g) * 128 + 2 * lane; hr = st[0]; hi = st[1]; }
    const GAS bf16* UA = WSP(bf16, WS_PROJ);
    GAS bf16* YS = WSP(bf16, WS_YS5) + (size_t)dr * SEG_ELEMS;
    const int nch = L / 16;
    u32x4 uq[4] = {{0u, 0u, 0u, 0u}, {0u, 0u, 0u, 0u}, {0u, 0u, 0u, 0u}, {0u, 0u, 0u, 0u}};
#define S5_ULOAD(cc_) (*(const GAS u32x4*)(UA + (size_t)(mbase + 16 * (dr ? nch - 1 - (cc_) : (cc_)) + r) * WB + 16 * g + 8 * q))
    if (q < 2) {
#pragma unroll
        for (int k = 0; k < 4; ++k) uq[k] = S5_ULOAD(k); }
    for (int cc = 0; cc < nch; ++cc) {
        const int t0 = 16 * (dr ? nch - 1 - cc : cc);
        const bf16x8 uf = __builtin_bit_cast(bf16x8, uq[0]);
        uq[0] = uq[1]; uq[1] = uq[2]; uq[2] = uq[3];
        if (q < 2 && cc + 4 < nch) uq[3] = S5_ULOAD(cc + 4);
#pragma unroll
        for (int nt = 0; nt < 8; ++nt) { const f32x4 x = __builtin_amdgcn_mfma_f32_16x16x32_bf16(bzf[nt], uf, (f32x4){0.f, 0.f, 0.f, 0.f}, 0, 0, 0);
            *(LAS f32x4*)(XS + r * 132 + 16 * nt + 4 * q) = x; }
        LDS_WAIT();
#pragma unroll 4
        for (int s = 0; s < 16; ++s) { const int tt = dr ? 15 - s : s;
            const f32x2 x2 = *(const LAS f32x2*)(XS + tt * 132 + 2 * lane);
            const float nr = lr * hr - li * hi + x2[0], ni = lr * hi + li * hr + x2[1]; hr = nr; hi = ni;
            ((LAS unsigned*)HS)[tt * 68 + lane] = cvt_pk_bf16(nr, ni); }
        LDS_WAIT();
        f32x4 y = {0.f, 0.f, 0.f, 0.f};
#pragma unroll
        for (int ks = 0; ks < 4; ++ks) { const bf16x8 hf = *(const LAS bf16x8*)(HS + r * 136 + 32 * ks + 8 * q); y = __builtin_amdgcn_mfma_f32_16x16x32_bf16(cmf[ks], hf, y, 0, 0, 0); }
        { u32x2 yw; yw.x = cvt_pk_bf16(y[0], y[1]); yw.y = cvt_pk_bf16(y[2], y[3]); *(GAS u32x2*)(YS + (size_t)(mbase + t0 + r) * WB + 16 * g + 4 * q) = yw; }
        LDS_WAIT();
    }
    if (!lat) { GAS float* st = GOUT + 25165824 + ((size_t)((sq * 2 + l) * 2 + dr) * 128 + g) * 128 + 2 * lane; st[0] = hr; st[1] = hi; }
#undef S5_ULOAD
}
__device__ __forceinline__ void s5_wg_unit(const Frame& F, int l, int u) {
    LAS unsigned char* wl = F.lds + F.wave * 12800;
    if (u < 64) { const int idx = u * 8 + F.wave; s5_item(F, l, 16 + (idx >> 8), (idx >> 1) & 127, idx & 1, wl); }
    else for (int k = 0; k < 4; ++k) { const int id = (u - 64) * 32 + F.wave * 4 + k; s5_item(F, l, id >> 8, (id >> 1) & 127, id & 1, wl); }
}

__device__ __forceinline__ float neg_expm1(float x) {
    if (x > -0.3f) return -x * (1.f + x * (0.5f + x * (0.16666667f + x * (0.041666668f + x * 0.0083333338f))));
    return 1.f - __expf(x);
}
__device__ __forceinline__ void lru_unit(const Frame& F, int l, int sq, int n, int dr) {
    const int lane = F.lane, r = lane & 15, q = lane >> 4, w = F.wave;
    const bool lat = sq >= 16; const int L = lat ? 1024 : 256, mbase = lat ? NCTX + (sq - 16) * 1024 : sq * 256, npan = L / 256;
    LAS bf16* XC = (LAS bf16*)F.lds;
    const int d = 16 * w + r, ch = 128 * n + d;
    const GAS bf16* wta = WSP(bf16, WS_WLRU) + ((size_t)(l * 64 + (dr * 2 + 0) * 16 + n) * 128 + d) * 128;
    const GAS bf16* wtx = WSP(bf16, WS_WLRU) + ((size_t)(l * 64 + (dr * 2 + 1) * 16 + n) * 128 + d) * 128;
    bf16x8 wa[4], wx[4];
#pragma unroll
    for (int ks = 0; ks < 4; ++ks) { wa[ks] = *(const bf16x8*)(wta + 32 * ks + 8 * q); wx[ks] = *(const bf16x8*)(wtx + 32 * ks + 8 * q); }
    const float ba = GIN(24)[(l * 2 + dr) * WB + ch], bx = GIN(26)[(l * 2 + dr) * WB + ch], lamv = GIN(27)[(l * 2 + dr) * WB + ch];
    const float e1 = expf(-fabsf(lamv)), u1 = 1.f + e1, l1p = (u1 == 1.f) ? e1 : __logf(u1) * (e1 / (u1 - 1.f));
    const float c8 = -8.f * (fmaxf(-lamv, 0.f) + l1p);
    const float c8l2 = c8 * 1.44269504f, nba = -1.44269504f * ba, nbx = -1.44269504f * bx;
    float carry = lat ? GIN(3)[((sq - 16) * 2 + l) * 2 * WB + dr * WB + ch] : 0.f;
    const int cg = F.tid & 15; float cw[4][8], cb[8];
#pragma unroll
    for (int e = 0; e < 8; ++e) { cb[e] = GIN(22)[l * WB + 128 * n + 8 * cg + e];
#pragma unroll
        for (int k = 0; k < 4; ++k) cw[k][e] = GIN(21)[(l * 4 + k) * WB + 128 * n + 8 * cg + e]; }
    const GAS bf16* XB = WSP(bf16, WS_PROJ) + 2 * SEG_ELEMS;
    GAS bf16* HL = WSP(bf16, WS_HL) + (size_t)dr * SEG_ELEMS;
    for (int pp = 0; pp < npan; ++pp) {
        const int m0 = mbase + 256 * (dr ? npan - 1 - pp : pp);
        __syncthreads();
#pragma unroll 2
        for (int it = 0; it < 8; ++it) { const int t = (F.tid >> 4) + 32 * it;
            float o[8];
#pragma unroll
            for (int e = 0; e < 8; ++e) o[e] = cb[e];
#pragma unroll
            for (int k = 0; k < 4; ++k) { const int ts = t + k - 2; const bool ok = lat ? ((ts >= 0) && ((ts >> 6) == (t >> 6))) : (ts >= 0 && ts < 256);
                if (ok) { const u32x4 xv = *(const GAS u32x4*)(XB + (size_t)(m0 + ts) * WB + 128 * n + 8 * cg);
                    o[0] += cw[k][0] * bflo(xv.x); o[1] += cw[k][1] * bfhi(xv.x); o[2] += cw[k][2] * bflo(xv.y); o[3] += cw[k][3] * bfhi(xv.y);
                    o[4] += cw[k][4] * bflo(xv.z); o[5] += cw[k][5] * bfhi(xv.z); o[6] += cw[k][6] * bflo(xv.w); o[7] += cw[k][7] * bfhi(xv.w); } }
            u32x4 wv; wv.x = cvt_pk_bf16(o[0], o[1]); wv.y = cvt_pk_bf16(o[2], o[3]); wv.z = cvt_pk_bf16(o[4], o[5]); wv.w = cvt_pk_bf16(o[6], o[7]);
            *(LAS u32x4*)(XC + t * 136 + 8 * cg) = wv; }
        __syncthreads();
#pragma unroll 1
        for (int hh = 0; hh < 2; ++hh) {
            const int half = dr ? 1 - hh : hh;
            f32x4 R[8], I[8];
#pragma unroll
            for (int mt = 0; mt < 8; ++mt) { R[mt] = (f32x4){0.f, 0.f, 0.f, 0.f}; I[mt] = (f32x4){0.f, 0.f, 0.f, 0.f}; }
#pragma unroll
            for (int ks = 0; ks < 4; ++ks)
#pragma unroll
                for (int mt = 0; mt < 8; ++mt) { const bf16x8 af = *(const LAS bf16x8*)(XC + (128 * half + 16 * mt + r) * 136 + 32 * ks + 8 * q);
                    R[mt] = __builtin_amdgcn_mfma_f32_16x16x32_bf16(af, wa[ks], R[mt], 0, 0, 0); I[mt] = __builtin_amdgcn_mfma_f32_16x16x32_bf16(af, wx[ks], I[mt], 0, 0, 0); }
#pragma unroll
            for (int mi = 0; mi < 8; ++mi) {
                const int mt = dr ? 7 - mi : mi; const int tb = 128 * half + 16 * mt + 4 * q;
                f32x4 a, b;
                { const f32x4 er_ = R[mt] * (-1.44269504f) + nba, ei_ = I[mt] * (-1.44269504f) + nbx; f32x4 dr_, di_, xc_;
#pragma unroll
                  for (int i = 0; i < 4; ++i) { dr_[i] = __builtin_amdgcn_exp2f(er_[i]); di_[i] = __builtin_amdgcn_exp2f(ei_[i]); xc_[i] = bf2f(XC[(tb + i) * 136 + d]); }
                  dr_ = dr_ + 1.f; di_ = di_ + 1.f; f32x4 rr, ig;
#pragma unroll
                  for (int i = 0; i < 4; ++i) { rr[i] = frcp(dr_[i]); ig[i] = frcp(di_[i]); }
                  const f32x4 la2 = rr * c8l2;
#pragma unroll
                  for (int i = 0; i < 4; ++i) a[i] = __builtin_amdgcn_exp2f(la2[i]);
                  f32x4 m2 = 1.f - a * a;
#pragma unroll
                  for (int i = 0; i < 4; ++i) m2[i] = __builtin_amdgcn_sqrtf(fmaxf(m2[i], 0.f));
                  b = m2 * ig * xc_; }
                float PA[4], PB[4], h[4];
                if (!dr) { PA[0] = a[0]; PB[0] = b[0];
#pragma unroll
                    for (int i = 1; i < 4; ++i) { PA[i] = a[i] * PA[i - 1]; PB[i] = a[i] * PB[i - 1] + b[i]; } }
                else { PA[3] = a[3]; PB[3] = b[3];
#pragma unroll
                    for (int i = 2; i >= 0; --i) { PA[i] = a[i] * PA[i + 1]; PB[i] = a[i] * PB[i + 1] + b[i]; } }
                const float TA = dr ? PA[0] : PA[3], TB = dr ? PB[0] : PB[3];
                const int qq = dr ? 3 - q : q;
                float pa = dr ? SHFL_DOWN(TA, 16, F.lane) : SHFL_UP(TA, 16, F.lane), pb = dr ? SHFL_DOWN(TB, 16, F.lane) : SHFL_UP(TB, 16, F.lane);
                float S1A = TA, S1B = TB; if (qq >= 1) { S1A = TA * pa; S1B = TA * pb + TB; }
                pa = dr ? SHFL_DOWN(S1A, 32, F.lane) : SHFL_UP(S1A, 32, F.lane); pb = dr ? SHFL_DOWN(S1B, 32, F.lane) : SHFL_UP(S1B, 32, F.lane);
                float IA = S1A, IB = S1B; if (qq >= 2) { IA = S1A * pa; IB = S1A * pb + S1B; }
                pa = dr ? SHFL_DOWN(IA, 16, F.lane) : SHFL_UP(IA, 16, F.lane); pb = dr ? SHFL_DOWN(IB, 16, F.lane) : SHFL_UP(IB, 16, F.lane);
                float EA = 1.f, EB = 0.f; if (qq >= 1) { EA = pa; EB = pb; }
                const float TTA = shfl_src(IA, (dr ? 0 : 48) + r), TTB = shfl_src(IB, (dr ? 0 : 48) + r);
                const float sin_ = EA * carry + EB;
#pragma unroll
                for (int i = 0; i < 4; ++i) { h[i] = PA[i] * sin_ + PB[i]; HL[(size_t)(m0 + tb + i) * WB + ch] = f2bf(h[i]); }
                carry = TTA * carry + TTB;
            }
        }
    }
    if (!lat && q == 0) GOUT[26214400 + ((sq * 2 + l) * 2 + dr) * WB + ch] = carry;
    __syncthreads();
}
__device__ __forceinline__ void hgrn_unit(const Frame& F, int l, int sq, int hd, int dr) {
    const int lane = F.lane, r = lane & 15, q = lane >> 4, w = F.wave, tid = F.tid;
    const bool lat = sq >= 16; const int L = lat ? 1024 : 256, mbase = lat ? NCTX + (sq - 16) * 1024 : sq * 256, nch = L / 16;
    constexpr int HG_BUF = 22528;
    const GAS bf16* QC = WSP(bf16, WS_PROJ) + 4 * SEG_ELEMS; const GAS bf16* FC = WSP(bf16, WS_PROJ) + (size_t)(5 + dr) * SEG_ELEMS; const GAS bf16* IC = WSP(bf16, WS_PROJ) + 7 * SEG_ELEMS;
    GAS bf16* O = WSP(bf16, WS_O) + (size_t)dr * SEG_ELEMS;
    const int k = 16 * w + r, chk = hd * 128 + k;
    float lb = 0.f; if (l == 1) lb = sigm(GIN(28)[(2 + dr) * WB + chk] - GIN(28)[dr * WB + chk]);
    f32x4 S[8];
    if (lat) { const GAS float* st = GIN(4) + ((size_t)((((sq - 16) * 2 + l) * 2 + dr) * 16 + hd) * 128) * 128 + 16 * w + r;
#pragma unroll
        for (int kt = 0; kt < 8; ++kt)
#pragma unroll
            for (int i = 0; i < 4; ++i) S[kt][i] = st[(size_t)(16 * kt + 4 * q + i) * 128]; }
    else {
#pragma unroll
        for (int kt = 0; kt < 8; ++kt) S[kt] = (f32x4){0.f, 0.f, 0.f, 0.f}; }
    bf16 fraw[4], qraw[4]; u32x2 vraw;
    const int vs = tid >> 5, v4 = 4 * (tid & 31);
#define HG_LOAD(c_) do { _Pragma("unroll") for (int jj = 0; jj < 4; ++jj) { const int j_ = 16 * (c_) + 4 * q + jj; const int m_ = mbase + (dr ? L - 1 - j_ : j_); \
            fraw[jj] = FC[(size_t)m_ * WB + chk]; qraw[jj] = QC[(size_t)m_ * WB + chk]; } \
        { const int j_ = 16 * (c_) + vs; const int m_ = mbase + (dr ? L - 1 - j_ : j_); vraw = *(const GAS u32x2*)(IC + (size_t)m_ * WB + hd * 128 + v4); } } while (0)
#define HG_PREP(c_, BO_) do { LAS bf16* QE_ = (LAS bf16*)(F.lds + (BO_)); LAS bf16* KE_ = (LAS bf16*)(F.lds + (BO_) + 4352); LAS bf16* KDT_ = (LAS bf16*)(F.lds + (BO_) + 8704); \
        LAS bf16* VT_ = (LAS bf16*)(F.lds + (BO_) + 14848); LAS float* DL_ = (LAS float*)(F.lds + (BO_) + 20992); \
          \
        float gg[4], gi[4], kk[4], qv[4]; \
        _Pragma("unroll") for (int jj = 0; jj < 4; ++jj) { const float f = bf2f(fraw[jj]); qv[jj] = bf2f(qraw[jj]); const float e = fminf(__builtin_amdgcn_exp2f(f * (-1.44269504f)), 1e30f); \
            const float d = 1.f + e, n = 1.f + lb * e; const float g = n * frcp(d); gg[jj] = g; gi[jj] = lb == 0.f ? d : d * frcp(n); kk[jj] = 1.f - g; } \
        const u32x2 vv = vraw; \
        if ((c_) + 1 < nch) HG_LOAD((c_) + 1); \
        float pg[4], pd[4]; pg[0] = gg[0]; pg[1] = pg[0] * gg[1]; pg[2] = pg[1] * gg[2]; pg[3] = pg[2] * gg[3]; pd[0] = gi[0]; pd[1] = pd[0] * gi[1]; pd[2] = pd[1] * gi[2]; pd[3] = pd[2] * gi[3]; \
        const float Tg = pg[3], Td = pd[3]; \
        const float a1 = SHFL_UP(Tg, 16, F.lane), b1 = SHFL_UP(Td, 16, F.lane); const float i1g = q >= 1 ? Tg * a1 : Tg, i1d = q >= 1 ? Td * b1 : Td; \
        const float a2 = SHFL_UP(i1g, 32, F.lane), b2 = SHFL_UP(i1d, 32, F.lane); const float incg = q >= 2 ? i1g * a2 : i1g, incd = q >= 2 ? i1d * b2 : i1d; \
        const float a3 = SHFL_UP(incg, 16, F.lane), b3 = SHFL_UP(incd, 16, F.lane); const float excg = q >= 1 ? a3 : 1.f, excd = q >= 1 ? b3 : 1.f; \
        const float dlv = shfl_src(incg, 48 + r); \
        _Pragma("unroll") for (int jj = 0; jj < 4; ++jj) { const int j = 4 * q + jj; const float kev = kk[jj] * fminf(excd * pd[jj], 1e35f); \
            QE_[j * 136 + k] = f2bf(qv[jj] * (excg * pg[jj])); KE_[j * 136 + k] = f2bf(kev); KDT_[k * 24 + j] = f2bf(kev * dlv); } \
        if (q == 0) DL_[k] = dlv; \
        VT_[(v4 + 0) * 24 + vs] = (bf16)(vv.x & 0xffffu); VT_[(v4 + 1) * 24 + vs] = (bf16)(vv.x >> 16); VT_[(v4 + 2) * 24 + vs] = (bf16)(vv.y & 0xffffu); VT_[(v4 + 3) * 24 + vs] = (bf16)(vv.y >> 16); } while (0)
    HG_LOAD(0);
    HG_PREP(0, 0);
    __syncthreads();
    for (int c = 0; c < nch; ++c) {
        const int bo = (c & 1) * HG_BUF;
        if (c + 1 < nch) HG_PREP(c + 1, HG_BUF - bo);
        LAS bf16* QE = (LAS bf16*)(F.lds + bo); LAS bf16* KE = (LAS bf16*)(F.lds + bo + 4352); LAS bf16* KDT = (LAS bf16*)(F.lds + bo + 8704); LAS bf16* VT = (LAS bf16*)(F.lds + bo + 14848); LAS float* DL = (LAS float*)(F.lds + bo + 20992);
        f32x4 pt = {0.f, 0.f, 0.f, 0.f};
#pragma unroll
        for (int ks = 0; ks < 4; ++ks) { const bf16x8 ka = *(const LAS bf16x8*)(KE + r * 136 + 32 * ks + 8 * q), qb = *(const LAS bf16x8*)(QE + r * 136 + 32 * ks + 8 * q);
            pt = __builtin_amdgcn_mfma_f32_16x16x32_bf16(ka, qb, pt, 0, 0, 0); }
#pragma unroll
        for (int i = 0; i < 4; ++i) if (4 * q + i > r) pt[i] = 0.f;
        u32x4 pw = {cvt_pk_bf16(pt[0], pt[1]), cvt_pk_bf16(pt[2], pt[3]), 0u, 0u};
        u32x4 vw = {0u, 0u, 0u, 0u}; { const u32x2 t2 = *(const LAS u32x2*)(VT + (16 * w + r) * 24 + 4 * q); vw.x = t2.x; vw.y = t2.y; }
        f32x4 o = __builtin_amdgcn_mfma_f32_16x16x32_bf16(__builtin_bit_cast(bf16x8, pw), __builtin_bit_cast(bf16x8, vw), (f32x4){0.f, 0.f, 0.f, 0.f}, 0, 0, 0);
#pragma unroll
        for (int ks = 0; ks < 4; ++ks) {
            const u32x2 qa0 = *(const LAS u32x2*)(QE + r * 136 + 32 * ks + 4 * q), qa1 = *(const LAS u32x2*)(QE + r * 136 + 32 * ks + 16 + 4 * q);
            const u32x4 qa = {qa0.x, qa0.y, qa1.x, qa1.y};
            const u32x4 sb = {cvt_pk_bf16(S[2 * ks][0], S[2 * ks][1]), cvt_pk_bf16(S[2 * ks][2], S[2 * ks][3]), cvt_pk_bf16(S[2 * ks + 1][0], S[2 * ks + 1][1]), cvt_pk_bf16(S[2 * ks + 1][2], S[2 * ks + 1][3])};
            o = __builtin_amdgcn_mfma_f32_16x16x32_bf16(__builtin_bit_cast(bf16x8, qa), __builtin_bit_cast(bf16x8, sb), o, 0, 0, 0);
        }
#pragma unroll
        for (int i = 0; i < 4; ++i) { const int j = 16 * c + 4 * q + i; const int m = mbase + (dr ? L - 1 - j : j); O[(size_t)m * WB + hd * 128 + 16 * w + r] = f2bf(o[i]); }
        u32x4 vb = {0u, 0u, 0u, 0u}; if (q < 2) vb = *(const LAS u32x4*)(VT + (16 * w + r) * 24 + 8 * q);
#pragma unroll
        for (int kt = 0; kt < 8; ++kt) {
            const f32x4 dl = *(const LAS f32x4*)(DL + 16 * kt + 4 * q);
            u32x4 ka = {0u, 0u, 0u, 0u}; if (q < 2) ka = *(const LAS u32x4*)(KDT + (16 * kt + r) * 24 + 8 * q);
            S[kt] = __builtin_amdgcn_mfma_f32_16x16x32_bf16(__builtin_bit_cast(bf16x8, ka), __builtin_bit_cast(bf16x8, vb), S[kt] * dl, 0, 0, 0);
        }
        __syncthreads();
    }
    if (!lat) { GAS float* st = GOUT + 26345472 + ((size_t)(((sq * 2 + l) * 2 + dr) * 16 + hd) * 128) * 128 + 16 * w + r;
#pragma unroll
        for (int kt = 0; kt < 8; ++kt)
#pragma unroll
            for (int i = 0; i < 4; ++i) st[(size_t)(16 * kt + 4 * q + i) * 128] = S[kt][i]; }
#undef HG_LOAD
#undef HG_PREP
}
#define MIXQ_LOOP(HEAD, N, NLONG, BODY) { __syncthreads(); if (F.tid == 0) qw[0] = (int)__hip_atomic_fetch_add((HEAD), 1u, __ATOMIC_RELAXED, __HIP_MEMORY_SCOPE_AGENT); __syncthreads(); \
        int u = __builtin_amdgcn_readfirstlane(qw[0]); \
        while (u < (N)) { const bool pre_ = u >= (NLONG); unsigned nx_ = 0u; if (pre_ && F.tid == 0) nx_ = __hip_atomic_fetch_add((HEAD), 1u, __ATOMIC_RELAXED, __HIP_MEMORY_SCOPE_AGENT); \
            BODY \
            __syncthreads(); if (F.tid == 0) qw[0] = pre_ ? (int)nx_ : (int)__hip_atomic_fetch_add((HEAD), 1u, __ATOMIC_RELAXED, __HIP_MEMORY_SCOPE_AGENT); __syncthreads(); \
            u = __builtin_amdgcn_readfirstlane(qw[0]); } }
__device__ __forceinline__ void mixers_phase(const Frame& F0_, int l, GAS unsigned* qhead) {
    volatile LAS int* qw = (volatile LAS int*)(F0_.lds + LDSCTL_OFF + 256);
    const int vl_ = F0_.vcu & 31;
    const int cls = F0_.G == 256 ? (vl_ < 8 ? 0 : (vl_ < 16 ? 1 : 2)) : 3;
#pragma unroll 1
    for (int pass = 0; pass < 2; ++pass) {
        const int ps = launder_s(pass);
        for (int rp = 0; rp < (int)((PROBE_MASK >> 16) & 1u) + 1; ++rp) { const Frame F = launder(F0_); if (ps == 1 || cls >= 2) { MIXQ_LOOP(qhead + 64 + 16 * rp, 192, 0, { s5_wg_unit(F, l, u); }) } }
        for (int rp = 0; rp < (int)((PROBE_MASK >> 18) & 1u) + 1; ++rp) { const Frame F = launder(F0_); GAS unsigned* hd_ = (ps == 0 ? qhead + 32 : qhead + 128) + 16 * rp; const int n_ = ps == 0 ? 64 : 512, base_ = ps == 0 ? 0 : 64, nl_ = ps == 0 ? 64 : 0;
          if (ps == 1 || cls == 1 || cls == 3) { MIXQ_LOOP(hd_, n_, nl_, { const int ub = u + base_; if (ub < 64) hgrn_unit(F, l, 16 + (ub >> 5), (ub >> 1) & 15, ub & 1); else { const int j = ub - 64; hgrn_unit(F, l, j >> 5, (j >> 1) & 15, j & 1); } }) } }
        for (int rp = 0; rp < (int)((PROBE_MASK >> 17) & 1u) + 1; ++rp) { const Frame F = launder(F0_); GAS unsigned* hd_ = (ps == 0 ? qhead : qhead + 96) + 16 * rp; const int n_ = ps == 0 ? 64 : 512, base_ = ps == 0 ? 0 : 64, nl_ = ps == 0 ? 64 : 0;
          if (ps == 1 || cls == 0 || cls == 3) { MIXQ_LOOP(hd_, n_, nl_, { const int ub = u + base_; if (ub < 64) lru_unit(F, l, 16 + (ub >> 5), (ub >> 1) & 15, ub & 1); else { const int j = ub - 64; lru_unit(F, l, j >> 5, (j >> 1) & 15, j & 1); } }) } }
    }
    __syncthreads();
}

__device__ __forceinline__ void combine_phase(const Frame& F, int l) {
    const int gw = F.vcu * 8 + F.wave, NGW = F.G * 8, lane = F.lane;
    const GAS bf16* Y0 = WSP(bf16, WS_YS5); const GAS bf16* Y1 = Y0 + SEG_ELEMS; const GAS bf16* H0 = WSP(bf16, WS_HL); const GAS bf16* H1 = H0 + SEG_ELEMS; const GAS bf16* O0 = WSP(bf16, WS_O); const GAS bf16* O1 = O0 + SEG_ELEMS;
    const GAS bf16* UA = WSP(bf16, WS_PROJ); const GAS bf16* GB = UA + 3 * SEG_ELEMS; const GAS bf16* GC = UA + 8 * SEG_ELEMS;
    GAS bf16* YAP = WSP(bf16, WS_YAP); GAS bf16* YB = WSP(bf16, WS_YABC) + SEG_ELEMS; GAS bf16* YC = WSP(bf16, WS_YABC) + 2 * SEG_ELEMS;
    const GAS float* dsk = GIN(18) + (size_t)l * WB; const GAS float* nw = GIN(29) + (size_t)l * WB;
    for (int m = gw; m < NTOK; m += NGW) {
        const size_t ro = (size_t)m * WB;
        u32x4 ya[4], yb[4], uv[4], ha[4], hb[4], gb[4], oa[4], ob[4], gc[4];
#pragma unroll
        for (int j = 0; j < 4; ++j) { const size_t o = ro + 512 * j + 8 * lane;
            ya[j] = *(const GAS u32x4*)(Y0 + o); yb[j] = *(const GAS u32x4*)(Y1 + o); uv[j] = *(const GAS u32x4*)(UA + o);
            ha[j] = *(const GAS u32x4*)(H0 + o); hb[j] = *(const GAS u32x4*)(H1 + o); gb[j] = *(const GAS u32x4*)(GB + o);
            oa[j] = *(const GAS u32x4*)(O0 + o); ob[j] = *(const GAS u32x4*)(O1 + o); gc[j] = *(const GAS u32x4*)(GC + o); }
#pragma unroll
        for (int j = 0; j < 4; ++j) { const int ch = 512 * j + 8 * lane; const size_t o = ro + ch;
            { const f32x4 d0 = *(const GAS f32x4*)(dsk + ch), d1 = *(const GAS f32x4*)(dsk + ch + 4); u32x4 wv;
#pragma unroll
              for (int q = 0; q < 4; ++q) { const float dl = q < 2 ? d0[2 * q] : d1[2 * q - 4], dh = q < 2 ? d0[2 * q + 1] : d1[2 * q - 3];
                  wv[q] = cvt_pk_bf16(gelu_tanh(bflo(ya[j][q]) + bflo(yb[j][q]) + dl * bflo(uv[j][q])), gelu_tanh(bfhi(ya[j][q]) + bfhi(yb[j][q]) + dh * bfhi(uv[j][q]))); }
              WT_ST128(WT_RSRC(YAP), 16 * lane, (m * WB + 512 * j) * 2, wv);
              int w0 = 0, w1 = 0;
              w0 = __builtin_amdgcn_cvt_pk_fp8_f32(__builtin_amdgcn_fmed3f(bflo(wv[0]), -448.f, 448.f), __builtin_amdgcn_fmed3f(bfhi(wv[0]), -448.f, 448.f), w0, false);
              w0 = __builtin_amdgcn_cvt_pk_fp8_f32(__builtin_amdgcn_fmed3f(bflo(wv[1]), -448.f, 448.f), __builtin_amdgcn_fmed3f(bfhi(wv[1]), -448.f, 448.f), w0, true);
              w1 = __builtin_amdgcn_cvt_pk_fp8_f32(__builtin_amdgcn_fmed3f(bflo(wv[2]), -448.f, 448.f), __builtin_amdgcn_fmed3f(bfhi(wv[2]), -448.f, 448.f), w1, false);
              w1 = __builtin_amdgcn_cvt_pk_fp8_f32(__builtin_amdgcn_fmed3f(bflo(wv[3]), -448.f, 448.f), __builtin_amdgcn_fmed3f(bfhi(wv[3]), -448.f, 448.f), w1, true);
              u32x2 w8; w8.x = (unsigned)w0; w8.y = (unsigned)w1; WT_ST64(WT_RSRC(WSP(unsigned char, WS_TMP) + 32 * MiB), 8 * lane, m * WB + 512 * j, w8); }
            { u32x4 wv;
#pragma unroll
              for (int q = 0; q < 4; ++q) wv[q] = cvt_pk_bf16((bflo(ha[j][q]) + bflo(hb[j][q])) * bflo(gb[j][q]), (bfhi(ha[j][q]) + bfhi(hb[j][q])) * bfhi(gb[j][q]));
              WT_ST128(WT_RSRC(YB), 16 * lane, (m * WB + 512 * j) * 2, wv); }
            { const f32x4 w0 = *(const GAS f32x4*)(nw + ch), w1 = *(const GAS f32x4*)(nw + ch + 4); float ol[4], oh[4], ss = 0.f;
#pragma unroll
              for (int q = 0; q < 4; ++q) { ol[q] = bflo(oa[j][q]) + bflo(ob[j][q]); oh[q] = bfhi(oa[j][q]) + bfhi(ob[j][q]); ss += ol[q] * ol[q] + oh[q] * oh[q]; }
#pragma unroll
              for (int sft = 1; sft < 16; sft <<= 1) ss += SHFL_XOR(ss, sft, lane);
              const float rs = 1.f / sqrtf(ss * (1.f / 128.f) + RMS_EPS); u32x4 wv;
#pragma unroll
              for (int q = 0; q < 4; ++q) { const float wl = q < 2 ? w0[2 * q] : w1[2 * q - 4], wh = q < 2 ? w0[2 * q + 1] : w1[2 * q - 3];
                  wv[q] = cvt_pk_bf16(ol[q] * rs * wl * bflo(gc[j][q]), oh[q] * rs * wh * bfhi(gc[j][q])); }
              WT_ST128(WT_RSRC(YC), 16 * lane, (m * WB + 512 * j) * 2, wv); }
        }
    }
}

constexpr int N_PHASES = 16;
__global__ void __launch_bounds__(512, 2) fwd_kernel(Args args) {
    extern __shared__ __attribute__((aligned(16))) unsigned char lds_raw[];
    Frame F0;
    F0.lds = (LAS unsigned char*)lds_raw; F0.tid = threadIdx.x; F0.lane = F0.tid & 63; F0.wave = __builtin_amdgcn_readfirstlane(F0.tid >> 6);
    F0.G = gridDim.x; { const int bx = blockIdx.x; F0.vcu = (F0.G % 8 == 0) ? (bx % 8) * (F0.G / 8) + bx / 8 : bx; }
    F0.in = args.in; F0.out = args.out; F0.ws = args.ws;
    for (int u = F0.tid; u < (LDS_BYTES - LDSCTL_OFF) / 4; u += 512) ((LAS unsigned*)(F0.lds + LDSCTL_OFF))[u] = 0u;
    __syncthreads();
    const int lo = args.ph_lo, hi = args.ph_hi;
    XcdBarrier bar; bar.bar = (unsigned*)(F0.ws + WS_CTL) + CW_BAR; bar.x = 0; bar.st = nullptr;
    if (hi - lo > 1) bar = xcd_barrier_post((unsigned*)(F0.ws + WS_CTL) + CW_BAR, (volatile LAS unsigned*)(F0.lds + LDSCTL_OFF + 64));
#define IN(k) (lo <= (k) && (k) < hi)
#define SEAM(k) do { if (IN(k) && IN((k) + 1)) xcd_barrier(bar); } while (0)

    if (IN(0)) REP(0) { const Frame P = launder(F0); p0_prologue(P); } SEAM(0);
#pragma unroll 1
    for (int l0 = 0; l0 < 2; ++l0) {
        const int pb = 1 + 7 * l0;
        if (IN(pb)) REP(pb) { const Frame P = launder(F0); const int l = launder_s(l0); if (l == 0) ln_phase<0>(P, 0); else ln_phase<1>(P, 1); } SEAM(pb);
        if (IN(pb + 1)) REP(pb + 1) {
#ifndef NO_G1
            { const Frame F = launder(F0); const int l = launder_s(l0);
              pg8::Gemm g{WSP(bf16, WS_H), (const GAS bf16*)(WSP(unsigned char, WS_WIN) + (size_t)l * (240 * MiB)), NTOK, 9 * WB, D};
              typedef pg8::StreamOrder<24, 72, 64> Ord; Ord S; S.init(F.G, launder_s((int)blockIdx.x), EpiProj::NSLAB);
              const SplitCtx sx{WSP(float, WS_SLAB), WSP(unsigned, WS_CTL) + CW_CNT + (pb + 1) * 8192, WSP(unsigned, WS_CTL) + CW_TMO, 1};
              EpiProj E{WSP(bf16, WS_PROJ), GIN(10) + (size_t)l * INC, sx, 0};
              pg8::gemm_phase<EpiProj, Ord, true, true, false>(F.lds, g, S, E, F.tid); }
            { const Frame F = launder(F0); const int l = launder_s(l0);
              pg8::Gemm g{(const GAS bf16*)WSP(unsigned char, WS_TMP), (const GAS bf16*)(WSP(unsigned char, WS_WIN) + (size_t)l * (240 * MiB) + 144 * MiB), NTOK, 6 * WB, D / 2};
              typedef pg8::TailOrder<24, 48, 32> Ord8; Ord8 S; S.init(F.G, launder_s((int)blockIdx.x), (24 * 72) % F.G);
              const SplitCtx sx{WSP(float, WS_SLAB), WSP(unsigned, WS_CTL) + CW_CNT + (pb + 1) * 8192, WSP(unsigned, WS_CTL) + CW_TMO, 1};
              EpiProj E{WSP(bf16, WS_PROJ), GIN(10) + (size_t)l * INC, sx, 1};
              pg8::gemm_phase<EpiProj, Ord8, true, true, true>(F.lds, g, S, E, F.tid); }
#endif
        } SEAM(pb + 1);
        if (IN(pb + 2)) REP(pb + 2) { { const Frame P = launder(F0); mixers_phase(P, launder_s(l0), (GAS unsigned*)(P.ws + WS_CTL) + CW_MIXQ + 256 * l0 + 512 * _r); } } SEAM(pb + 2);
        if (IN(pb + 3)) REP(pb + 3) { const Frame P = launder(F0); combine_phase(P, launder_s(l0)); } SEAM(pb + 3);
        if (IN(pb + 4)) REP(pb + 4) { const Frame F = launder(F0); const int l = launder_s(l0);
            pg8::Gemm g{(const GAS bf16*)(WSP(unsigned char, WS_TMP) + 32 * MiB), WSP(bf16, WS_WGLU) + (size_t)l * WB * WB, NTOK, WB, WB / 2}; typedef pg8::StreamOrder<24, 8, 16> Ord; Ord S; S.init(F.G, launder_s((int)blockIdx.x), EpiGlu::NSLAB);
            const SplitCtx sx{WSP(float, WS_SLAB), WSP(unsigned, WS_CTL) + CW_CNT + (pb + 4) * 8192, WSP(unsigned, WS_CTL) + CW_TMO, S.s - 1};
            EpiGlu E{WSP(bf16, WS_YAP), WSP(bf16, WS_PROJ) + SEG_ELEMS, WSP(bf16, WS_YABC), GIN(20) + (size_t)l * WB, sx};
#ifndef NO_G2
            pg8::gemm_phase<EpiGlu, Ord, true, true, true>(F.lds, g, S, E, F.tid);
#endif

        } SEAM(pb + 4);
        if (IN(pb + 5)) REP(pb + 5) { const Frame F = launder(F0); const int l = launder_s(l0);
            pg8::Gemm g{WSP(bf16, WS_YABC), WSP(bf16, WS_WBR) + (size_t)l * 3 * D * WB, 3 * NTOK, 3 * D, WB}; pg8::MergeOrder S; S.init(F.G, launder_s((int)blockIdx.x));
            const SplitCtx sx{WSP(float, WS_SLAB), WSP(unsigned, WS_CTL) + CW_CNT + (pb + 5) * 8192, WSP(unsigned, WS_CTL) + CW_TMO, 1};
            EpiMerge E{WSP(bf16, WS_PROJ), WSP(bf16, WS_MERGED), sx};
#ifndef NO_G3
            pg8::gemm_phase<EpiMerge, pg8::MergeOrder, true, true>(F.lds, g, S, E, F.tid);
#endif

        } SEAM(pb + 5);
        if (IN(pb + 6)) REP(pb + 6) { const Frame F = launder(F0); const int l = launder_s(l0);
            pg8::Gemm g{WSP(bf16, WS_MERGED), WSP(bf16, WS_WOUT) + (size_t)l * D * D, NTOK, D, D}; typedef pg8::StreamOrder<24, 16, 64> Ord; Ord S; S.init(F.G, launder_s((int)blockIdx.x), EpiOut::NSLAB, 1);
            const SplitCtx sx{WSP(float, WS_SLAB), WSP(unsigned, WS_CTL) + CW_CNT + (pb + 6) * 8192, WSP(unsigned, WS_CTL) + CW_TMO, S.s - 1};
            EpiOut E{GIN(32) + (size_t)l * D, WSP(float, WS_MOD) + (size_t)l * 3 * 12288, WSP(bf16, WS_V), sx};
#ifndef NO_G4
            pg8::gemm_phase<EpiOut, Ord, true, true>(F.lds, g, S, E, F.tid);
#endif

        } SEAM(pb + 6);
    }
    if (IN(15)) REP(15) { const Frame P = launder(F0); ln_phase<2>(P, 1); }
#undef IN
#undef SEAM
}

extern "C" void kernel_launch(void* const* d_in, const int* in_sizes, int n_in, void* d_out, int out_size, void* d_ws, size_t ws_size, hipStream_t stream) {
    static int grid = 0;
    if (grid == 0) {
        if (n_in != 35 || out_size != 43122688 || ws_size < WS_END) { fprintf(stderr, "kernel_launch: unexpected shapes: n_in %d out %d ws %zu (need %zu)\n", n_in, out_size, ws_size, (size_t)WS_END); grid = -1; return; }
        int dev = 0, cus = 0, per_cu = 0;
        if (hipGetDevice(&dev) != hipSuccess || hipDeviceGetAttribute(&cus, hipDeviceAttributeMultiprocessorCount, dev) != hipSuccess) { grid = -1; return; }
        if (hipFuncSetAttribute((const void*)fwd_kernel, hipFuncAttributeMaxDynamicSharedMemorySize, LDS_BYTES) != hipSuccess) { fprintf(stderr, "kernel_launch: hipFuncSetAttribute failed\n"); grid = -1; return; }
        if (hipOccupancyMaxActiveBlocksPerMultiprocessor(&per_cu, (const void*)fwd_kernel, 512, LDS_BYTES) != hipSuccess || per_cu < 1) fprintf(stderr, "kernel_launch: occupancy query reports %d\n", per_cu);
        (void)hipGetLastError();
        grid = cus;
    }
    if (grid < 0) return;
    (void)hipMemsetAsync((char*)d_ws + WS_CTL, 0, CTL_ZERO_BYTES, stream);
    Args a{};
    for (int i = 0; i < 35; ++i) a.in[i] = (const float*)d_in[i];
    a.out = (float*)d_out; a.ws = (unsigned char*)d_ws;
    if (MK_N_LAUNCHES == 1) { a.ph_lo = 0; a.ph_hi = N_PHASES; hipLaunchKernelGGL(fwd_kernel, dim3(grid), dim3(512), LDS_BYTES, stream, a); }
    else for (int p = 0; p < N_PHASES; ++p) { a.ph_lo = p; a.ph_hi = p + 1; hipLaunchKernelGGL(fwd_kernel, dim3(grid), dim3(512), LDS_BYTES, stream, a); }
}
```

```cpp
#include <hip/hip_runtime.h>
#include <cstdio>
#include <cstdint>

#ifndef MK_N_LAUNCHES
#define MK_N_LAUNCHES 1
#endif

#ifndef PROBE_MASK
#define PROBE_MASK 0u
#endif
#define REP(k) for (int _r = 0; _r < (int)(((PROBE_MASK) >> (k)) & 1u) + 1; ++_r)
#define LAS __attribute__((address_space(3)))
#define GAS __attribute__((address_space(1)))
typedef unsigned short bf16;
typedef short bf16x8 __attribute__((ext_vector_type(8)));
typedef short bf16x4 __attribute__((ext_vector_type(4)));
typedef float f32x4 __attribute__((ext_vector_type(4)));
typedef float f32x2 __attribute__((ext_vector_type(2)));
typedef unsigned u32x4 __attribute__((ext_vector_type(4)));
typedef unsigned u32x2 __attribute__((ext_vector_type(2)));

constexpr int D = 4096, WB = 2048, NTOK = 6144, NCTX = 4096, INC = 30720;
constexpr int NSEQ = 18;
constexpr float LN_EPS = 1e-5f, RMS_EPS = 1e-6f, DN_ALPHA = 1.41421356237f;

constexpr size_t MiB = 1u << 20;
constexpr size_t WS_CTL = 0, CTL_ZERO_BYTES = 1 * MiB;
constexpr size_t WS_MOD = 1 * MiB;
constexpr size_t WS_WLRU = 2 * MiB;
constexpr size_t WS_WGLU = 6 * MiB;
constexpr size_t WS_WBR = 22 * MiB;
constexpr size_t WS_WOUT = 118 * MiB;
constexpr size_t WS_WIN = 182 * MiB;
constexpr size_t WS_H = 662 * MiB;
constexpr size_t WS_PROJ = 710 * MiB;
constexpr size_t WS_YS5 = 1070 * MiB;
constexpr size_t WS_HL = 1166 * MiB;
constexpr size_t WS_O = 1262 * MiB;
constexpr size_t WS_YAP = 1358 * MiB;
constexpr size_t WS_YABC = 1382 * MiB;
constexpr size_t WS_TMP = 1454 * MiB;
constexpr size_t WS_MERGED = 1550 * MiB;
constexpr size_t WS_V = 1598 * MiB;
constexpr size_t WS_X1 = 1694 * MiB;
constexpr size_t WS_SLAB = 1790 * MiB;
constexpr size_t WS_END = 1854 * MiB;
constexpr size_t SEG_ELEMS = (size_t)NTOK * WB;
constexpr int CW_TMO = 0;
constexpr int CW_MIXQ = 1024;
constexpr int CW_BAR = 4096;
constexpr int CW_CNT = 16384;

constexpr int RING_BYTES = 131072;
constexpr int LDSCTL_OFF = RING_BYTES;
constexpr int LDS_BYTES = 147456;

__host__ __device__ __forceinline__ bool seg_is_fp8(int seg) { return seg >= 9; }
__host__ __device__ __forceinline__ int seg_local(int seg) { return seg_is_fp8(seg) ? seg - 9 : seg; }
__host__ __device__ __forceinline__ int seg_of_b(int bi) { return bi; }
__host__ __device__ __forceinline__ int seg_of_g(int gi) { return gi + 9; }
constexpr float W8_SCALE = 64.f;
__device__ __forceinline__ float bf2f(bf16 b) { return __uint_as_float(((unsigned)b) << 16); }
__device__ __forceinline__ float bflo(unsigned w) { return __uint_as_float(w << 16); }
__device__ __forceinline__ float bfhi(unsigned w) { return __uint_as_float(w & 0xffff0000u); }
typedef __bf16 bf16x2_t __attribute__((ext_vector_type(2)));
__device__ __forceinline__ unsigned cvt_pk_bf16(float lo, float hi) { const bf16x2_t v = {(__bf16)lo, (__bf16)hi}; return __builtin_bit_cast(unsigned, v); }
__device__ __forceinline__ bf16 f2bf(float f) { return (bf16)(cvt_pk_bf16(f, 0.f) & 0xffffu); }
__device__ __forceinline__ float frcp(float x) { return __builtin_amdgcn_rcpf(x); }
__device__ __forceinline__ float sigm(float x) { return frcp(1.f + __expf(-x)); }
__device__ __forceinline__ float siluf(float x) { return x * sigm(x); }
__device__ __forceinline__ float gelu_tanh(float y) { return y * sigm(1.5957691216f * (y + 0.044715f * y * y * y)); }
__device__ __forceinline__ float shfl_src(float v, int src) { return __builtin_bit_cast(float, __builtin_amdgcn_ds_bpermute(src << 2, __builtin_bit_cast(int, v))); }
#define SHFL_XOR(v, m, ln)  shfl_src((v), (ln) ^ (m))
#define SHFL_UP(v, d, ln)   shfl_src((v), (ln) >= (d) ? (ln) - (d) : (ln))
#define SHFL_DOWN(v, d, ln) shfl_src((v), (ln) + (d) < 64 ? (ln) + (d) : (ln))
__device__ __forceinline__ float wave_sum(float v, int lane) {
#pragma unroll
    for (int o = 1; o < 64; o <<= 1) v += SHFL_XOR(v, o, lane);
    return v;
}
#define LDS_WAIT() asm volatile("s_waitcnt lgkmcnt(0)" ::: "memory")

namespace pg8 {
#define PG8_LAS __attribute__((address_space(3)))
typedef unsigned short bf16_t;
constexpr int BM = 256, BK = 64, HALF = 128, HTB = HALF * BK * 2, STAGE_BYTES = 8 * HTB, NXCD = 8, WGM = 8;
__host__ __device__ __forceinline__ int lds_byte(int r, int c) { const int st = (r >> 4) * 2 + (c >> 5), rr = r & 15, cc = c & 31, ob = rr * 64 + cc * 2; return st * 1024 + (ob ^ (((ob >> 9) & 1) << 5)); }
__host__ __device__ __forceinline__ void stage_rc(int b, int& R, int& C) { const int st = b / 1024, sb = b % 1024, swz = sb ^ (((sb >> 9) & 1) << 5); R = (st >> 1) * 16 + swz / 64; C = (st & 1) * 32 + (swz % 64) / 2; }
__host__ __device__ __forceinline__ int perm32(int rho) { const int n = rho >> 4, i = rho & 15; return 8 * (i >> 2) + 4 * n + (i & 3); }
struct Unit { int pm, pn, k0, nk, role, r, part; };
constexpr int U_PUB = 1, U_OWN = 2, U_FIRST = 4, U_LAST = 8;
struct Gemm { const GAS bf16_t* A; const GAS bf16_t* Bt; int M, N, K; };
template <int NM, int NN, int NT> struct StreamOrder {
    static constexpr int nwg = NM * NN;
    int G, c, nfull, R, s, ls, own;
    __device__ __forceinline__ void init(int G_, int c_, int nslab, int own_ = 0) { G = G_; c = c_; nfull = nwg / G; R = nwg % G; s = 1; ls = 0; own = own_;
        if (R > 0 && (G % 8) == 0 && (R % 8) == 0 && G == (nslab + 1) * R) { if (G == 2 * R && NT % 4 == 0 && NT / 2 >= 4) { s = 2; ls = 1; } else if (G == 4 * R && NT % 8 == 0 && NT / 4 >= 4) { s = 4; ls = 2; } } }
    __device__ __forceinline__ void tile_of(int L, Unit& u) const {
        int wgid = L; { constexpr int q = nwg / NXCD, r = nwg % NXCD; const int xcd = wgid % NXCD, off = wgid / NXCD; wgid = (xcd < r ? xcd * (q + 1) : r * (q + 1) + (xcd - r) * q) + off; }
        constexpr int nig = WGM * NN; static_assert(NM % WGM == 0, "row groups of 8");
        const int gid = wgid / nig, fm = gid * WGM, rem = wgid % nig;
        u.pm = fm + (rem % WGM); u.pn = rem / WGM; }
    __device__ __forceinline__ bool next(int i, Unit& u) const {
        u.k0 = 0; u.nk = NT; u.role = U_FIRST | U_LAST; u.r = 0; u.part = 0;
        if (i < nfull) { tile_of(i * G + c, u); return true; }
        if (i > nfull || R == 0) return false;
        if (s == 1) { if (c >= R) return false; tile_of(nfull * G + c, u); return true; }
        const int j = c >> 3, xcd = c & 7; u.r = xcd + 8 * (j >> ls); u.part = j & (s - 1);
        tile_of(nfull * G + u.r, u); u.nk = NT >> ls; u.k0 = u.part * u.nk; u.role = ((own && u.part == s - 1) ? U_OWN : U_PUB) | U_FIRST | U_LAST; return true;
    }
    __device__ __forceinline__ void a_ready(const Unit&) const {}
    __device__ __forceinline__ void done(const Unit&) const {}
};
template <int NM, int NN, int NT> struct TailOrder : StreamOrder<NM, NN, NT> {
    int heavy, bal;
    __device__ __forceinline__ void init(int G_, int c_, int heavy_) { StreamOrder<NM, NN, NT>::init(G_, c_, 0); heavy = heavy_; const int light = G_ - heavy_;
        bal = (this->R > 0 && light > 0 && (G_ % 8) == 0 && (heavy_ % 8) == 0 && this->R % light == 0) ? this->R / light : 0; }
    __device__ __forceinline__ bool next(int i, Unit& u) const {
        u.k0 = 0; u.nk = NT; u.role = U_FIRST | U_LAST; u.r = 0; u.part = 0;
        if (i < this->nfull) { this->tile_of(i * this->G + this->c, u); return true; }
        if (bal == 0) { if (i > this->nfull || this->c >= this->R) return false; this->tile_of(this->nfull * this->G + this->c, u); return true; }
        const int j = i - this->nfull; if (this->c < heavy || j >= bal) return false;
        this->tile_of(this->nfull * this->G + j * (this->G - heavy) + (this->c - heavy), u); return true;
    }
};
struct MergeOrder {
    int G, c, nfull, R, s;
    __device__ __forceinline__ void init(int G_, int c_) { G = G_; c = c_; nfull = 384 / G; R = 384 % G; s = (R > 0 && (G % 8) == 0 && (R % 8) == 0 && G == 2 * R) ? 2 : 1; }
    __device__ __forceinline__ bool next(int i, Unit& u) const {
        u.k0 = 0; u.nk = 32; u.r = 0; u.part = 0;
        int ti, br;
        if (i < 3 * nfull) { ti = c + (i / 3) * G; br = i % 3; u.role = (br == 0 ? U_FIRST : 0) | (br == 2 ? U_LAST : 0); }
        else { const int i2 = i - 3 * nfull; if (R == 0) return false;
            if (s == 1) { if (c >= R || i2 >= 3) return false; ti = nfull * G + c; br = i2; u.role = (br == 0 ? U_FIRST : 0) | (br == 2 ? U_LAST : 0); }
            else { if (i2 >= 2) return false; const int j = c >> 3, xcd = c & 7; u.r = xcd + 8 * (j >> 1); u.part = j & 1; ti = nfull * G + u.r;
                if (u.part == 0) { br = i2; u.role = U_PUB | (i2 == 0 ? U_FIRST : U_LAST); if (i2 == 1) u.nk = 16; }
                else { br = 1 + i2; u.role = U_OWN | (i2 == 0 ? U_FIRST : U_LAST); if (i2 == 0) { u.k0 = 16; u.nk = 16; } } } }
        u.pm = br * 24 + (ti % 24); u.pn = br * 16 + (ti / 24); return true;
    }
    __device__ __forceinline__ void a_ready(const Unit&) const {}
    __device__ __forceinline__ void done(const Unit&) const {}
};

typedef int i32x4v __attribute__((ext_vector_type(4)));
typedef int i32x8v __attribute__((ext_vector_type(8)));
template <class Epi, class Sched, bool ALIGN_EPI = false, bool SP2 = false, bool FP8 = false>
__device__ __forceinline__ void gemm_phase(PG8_LAS unsigned char* lds, const Gemm g, const Sched& S, const Epi& E, const int tid) {
    const int wid = __builtin_amdgcn_readfirstlane(tid >> 6), lane = tid & 63, wr = wid >> 2, wc = wid & 3, fr = lane & 15, fq = lane >> 4;
    const int K = g.K;
    unsigned voffA[2], voffB[2];
#pragma unroll
    for (int i = 0; i < 2; ++i) { int R, C; stage_rc(tid * 16 + i * 8192, R, C); const int Rb = Epi::PERM ? ((R & ~31) + perm32(R & 31)) : R;
        voffA[i] = (unsigned)(R * K + C) * 2u; voffB[i] = (unsigned)(Rb * K + C) * 2u; }
    const size_t kstep = (size_t)(BK * 2);
    const size_t hstep = (size_t)HALF * K * 2;
    const size_t tstep = 2 * hstep;
    const unsigned ldsw = (unsigned)wid * 1024u;
    const int aoff = lds_byte(wr * 64 + fr, fq * 8), boff = lds_byte(wc * 32 + fr, fq * 8);
#define PG8_SA(b, h) (((b) * 2 + (h)) * HTB)
#define PG8_SB(b, h) ((4 + (b) * 2 + (h)) * HTB)
#define PG8_STAGE(bufoff, gbase, voff) do { const GAS char* gb_ = (const GAS char*)(gbase); asm volatile("" : "+s"(gb_)); _Pragma("unroll") for (int _i = 0; _i < 2; ++_i) { \
        unsigned vo_ = (voff)[_i]; asm volatile("" : "+v"(vo_)); __builtin_amdgcn_global_load_lds((const GAS unsigned*)(gb_ + vo_), (PG8_LAS unsigned*)(lds + (bufoff) + ldsw + _i * 8192), 16, 0, 0); } } while (0)
#define PG8_LDA(dst, b, h) do { if constexpr (FP8) { _Pragma("unroll") for (int m = 0; m < 4; ++m) { const i32x4v lo_ = *(const PG8_LAS i32x4v*)(lds + PG8_SA(b, h) + aoff + m * 2048), hi_ = *(const PG8_LAS i32x4v*)(lds + PG8_SA(b, h) + aoff + m * 2048 + 1024); dst##8[m] = __builtin_shufflevector(lo_, hi_, 0, 1, 2, 3, 4, 5, 6, 7); } } \
        else { _Pragma("unroll") for (int m = 0; m < 4; ++m) _Pragma("unroll") for (int k = 0; k < 2; ++k) dst[m][k] = *(const PG8_LAS bf16x8*)(lds + PG8_SA(b, h) + aoff + m * 2048 + k * 1024); } } while (0)
#define PG8_LDB(dst, b, h) do { if constexpr (FP8) { _Pragma("unroll") for (int n = 0; n < 2; ++n) { const i32x4v lo_ = *(const PG8_LAS i32x4v*)(lds + PG8_SB(b, h) + boff + n * 2048), hi_ = *(const PG8_LAS i32x4v*)(lds + PG8_SB(b, h) + boff + n * 2048 + 1024); dst##8[n] = __builtin_shufflevector(lo_, hi_, 0, 1, 2, 3, 4, 5, 6, 7); } } \
        else { _Pragma("unroll") for (int n = 0; n < 2; ++n) _Pragma("unroll") for (int k = 0; k < 2; ++k) dst[n][k] = *(const PG8_LAS bf16x8*)(lds + PG8_SB(b, h) + boff + n * 2048 + k * 1024); } } while (0)
#define PG8_MMA(ai, bj, At, Bt) do { __builtin_amdgcn_s_setprio(1); if constexpr (FP8) { _Pragma("unroll") for (int m = 0; m < 4; ++m) _Pragma("unroll") for (int n = 0; n < 2; ++n) \
            acc[ai][bj][m][n] = __builtin_amdgcn_mfma_scale_f32_16x16x128_f8f6f4(Bt##8[n], At##8[m], acc[ai][bj][m][n], 0, 0, 0, 0, 0, 0); } \
        else { _Pragma("unroll") for (int m = 0; m < 4; ++m) _Pragma("unroll") for (int n = 0; n < 2; ++n) _Pragma("unroll") for (int k = 0; k < 2; ++k) \
            acc[ai][bj][m][n] = __builtin_amdgcn_mfma_f32_16x16x32_bf16(Bt[n][k], At[m][k], acc[ai][bj][m][n], 0, 0, 0); } __builtin_amdgcn_s_setprio(0); } while (0)
#define PG8_WAIT_V(n) asm volatile("s_waitcnt vmcnt(" #n ")" ::: "memory")
#define PG8_WAIT_L(n) asm volatile("s_waitcnt lgkmcnt(" #n ")" ::: "memory")
#define PG8_BAR __builtin_amdgcn_s_barrier()
#define PG8_SCHED __builtin_amdgcn_sched_barrier(0)
#define PG8_RELANE unsigned lz_; asm volatile("s_mov_b32 %0, 0" : "=s"(lz_)); int le_ = (int)__builtin_amdgcn_mbcnt_hi(~0u, __builtin_amdgcn_mbcnt_lo(~0u, lz_))
    Unit cur, nxt; int ui = 0;
    if (!S.next(0, cur)) return;
    f32x4 acc[2][2][4][2];
#pragma unroll
    for (int a = 0; a < 2; ++a)
#pragma unroll
        for (int b = 0; b < 2; ++b)
#pragma unroll
            for (int m = 0; m < 4; ++m)
#pragma unroll
                for (int n = 0; n < 2; ++n) acc[a][b][m][n] = (f32x4){0.f, 0.f, 0.f, 0.f};
    bf16x8 At[4][2], B0[2][2], B1[2][2];
    i32x8v At8[4], B08[2], B18[2];
    const GAS char* cA = (const GAS char*)g.A + (size_t)cur.pm * tstep + (size_t)cur.k0 * kstep; const GAS char* cB = (const GAS char*)g.Bt + (size_t)cur.pn * tstep + (size_t)cur.k0 * kstep;
    S.a_ready(cur);
    if constexpr (SP2) {
        PG8_STAGE(PG8_SB(0, 0), cB, voffB); PG8_STAGE(PG8_SB(0, 1), cB + hstep, voffB); PG8_STAGE(PG8_SA(0, 0), cA, voffA); PG8_STAGE(PG8_SA(0, 1), cA + hstep, voffA);
        if (wr == 1) PG8_BAR;
        PG8_WAIT_V(2); PG8_BAR;
        PG8_STAGE(PG8_SB(1, 0), cB + kstep, voffB); PG8_STAGE(PG8_SA(1, 0), cA + kstep, voffA); PG8_STAGE(PG8_SB(1, 1), cB + hstep + kstep, voffB);
        PG8_WAIT_V(6); PG8_BAR;
    } else {
        PG8_STAGE(PG8_SB(0, 0), cB, voffB); PG8_STAGE(PG8_SA(0, 0), cA, voffA); PG8_STAGE(PG8_SB(0, 1), cB + hstep, voffB); PG8_STAGE(PG8_SA(0, 1), cA + hstep, voffA);
        if (wr == 1) PG8_BAR;
        PG8_WAIT_V(4); PG8_BAR;
        PG8_STAGE(PG8_SB(1, 0), cB + kstep, voffB); PG8_STAGE(PG8_SA(1, 0), cA + kstep, voffA); PG8_STAGE(PG8_SB(1, 1), cB + hstep + kstep, voffB);
        PG8_WAIT_V(6); PG8_BAR;
    }
    for (;;) {
        const bool has_next = S.next(ui + 1, nxt);
        const GAS char* nA = has_next ? (const GAS char*)g.A + (size_t)nxt.pm * tstep + (size_t)nxt.k0 * kstep : cA; const GAS char* nB = has_next ? (const GAS char*)g.Bt + (size_t)nxt.pn * tstep + (size_t)nxt.k0 * kstep : cB;
        const int nt = cur.nk;
        for (int t = 0; t < nt; t += 2) {
            const bool last = (t == nt - 2);
            const GAS char* a1 = cA + (size_t)(t + 1) * kstep;
            const GAS char* a2 = last ? nA : cA + (size_t)(t + 2) * kstep; const GAS char* b2 = last ? nB : cB + (size_t)(t + 2) * kstep;
            const GAS char* a3 = a2 + kstep; const GAS char* b3 = b2 + kstep;
            if (last && has_next) S.a_ready(nxt);
            if constexpr (SP2) {
            PG8_LDB(B0, 0, 0); PG8_LDB(B1, 0, 1); PG8_SCHED; PG8_LDA(At, 0, 0); PG8_STAGE(PG8_SA(1, 1), a1 + hstep, voffA);
            PG8_WAIT_V(8); PG8_WAIT_L(0); PG8_BAR; PG8_MMA(0, 0, At, B0); PG8_MMA(0, 1, At, B1); PG8_BAR; PG8_SCHED;
            PG8_LDA(At, 0, 1); PG8_STAGE(PG8_SB(0, 0), b2, voffB); PG8_STAGE(PG8_SB(0, 1), b2 + hstep, voffB); PG8_STAGE(PG8_SA(0, 0), a2, voffA);
            PG8_WAIT_V(8); PG8_WAIT_L(0); PG8_BAR; PG8_MMA(1, 0, At, B0); PG8_MMA(1, 1, At, B1); PG8_BAR; PG8_SCHED;
            PG8_LDB(B0, 1, 0); PG8_LDB(B1, 1, 1); PG8_SCHED; PG8_LDA(At, 1, 0); PG8_STAGE(PG8_SA(0, 1), a2 + hstep, voffA);
            PG8_WAIT_V(8); PG8_WAIT_L(0); PG8_BAR; PG8_MMA(0, 0, At, B0); PG8_MMA(0, 1, At, B1); PG8_BAR; PG8_SCHED;
            PG8_LDA(At, 1, 1); PG8_STAGE(PG8_SB(1, 0), b3, voffB); PG8_STAGE(PG8_SB(1, 1), b3 + hstep, voffB); PG8_STAGE(PG8_SA(1, 0), a3, voffA);
            PG8_WAIT_V(8); PG8_WAIT_L(0); PG8_BAR; PG8_MMA(1, 0, At, B0); PG8_MMA(1, 1, At, B1); PG8_BAR; PG8_SCHED;
            } else {
            PG8_LDB(B0, 0, 0); PG8_SCHED; PG8_LDA(At, 0, 0); PG8_STAGE(PG8_SA(1, 1), a1 + hstep, voffA);
            PG8_WAIT_L(8); PG8_BAR; PG8_WAIT_L(0); PG8_MMA(0, 0, At, B0); PG8_BAR; PG8_SCHED;
            PG8_LDB(B1, 0, 1); PG8_STAGE(PG8_SB(0, 0), b2, voffB);
            PG8_BAR; PG8_WAIT_L(0); PG8_MMA(0, 1, At, B1); PG8_BAR;
            PG8_LDA(At, 0, 1); PG8_STAGE(PG8_SA(0, 0), a2, voffA);
            PG8_BAR; PG8_WAIT_L(0); PG8_MMA(1, 0, At, B0); PG8_BAR; PG8_SCHED;
            PG8_STAGE(PG8_SB(0, 1), b2 + hstep, voffB);
            PG8_WAIT_V(6); PG8_BAR; PG8_MMA(1, 1, At, B1); PG8_BAR;
            PG8_LDB(B0, 1, 0); PG8_SCHED; PG8_LDA(At, 1, 0); PG8_STAGE(PG8_SA(0, 1), a2 + hstep, voffA);
            PG8_WAIT_L(8); PG8_BAR; PG8_WAIT_L(0); PG8_MMA(0, 0, At, B0); PG8_BAR; PG8_SCHED;
            PG8_LDB(B1, 1, 1); PG8_STAGE(PG8_SB(1, 0), b3, voffB);
            PG8_BAR; PG8_WAIT_L(0); PG8_MMA(0, 1, At, B1); PG8_BAR;
            PG8_LDA(At, 1, 1); PG8_STAGE(PG8_SA(1, 0), a3, voffA);
            PG8_BAR; PG8_WAIT_L(0); PG8_MMA(1, 0, At, B0); PG8_BAR; PG8_SCHED;
            PG8_STAGE(PG8_SB(1, 1), b3 + hstep, voffB);
            PG8_WAIT_V(6); PG8_BAR; PG8_MMA(1, 1, At, B1); PG8_BAR;
            }
        }
        if constexpr (ALIGN_EPI) { if (wr == 0) PG8_BAR; }
        if (!has_next) break;
        { PG8_RELANE; E(acc, cur, wr, wc, le_ & 15, le_ >> 4, wid, le_); } S.done(cur);
        if constexpr (!Epi::ACC_CHAIN) {
#pragma unroll
        for (int a = 0; a < 2; ++a)
#pragma unroll
            for (int b = 0; b < 2; ++b)
#pragma unroll
                for (int m = 0; m < 4; ++m)
#pragma unroll
                    for (int n = 0; n < 2; ++n) acc[a][b][m][n] = (f32x4){0.f, 0.f, 0.f, 0.f};
        }
        cur = nxt; cA = nA; cB = nB; ++ui;
        if constexpr (ALIGN_EPI) { if (wr == 1) PG8_BAR; }
    }
    { PG8_RELANE; E.last(acc, cur, wr, wc, le_ & 15, le_ >> 4, wid, le_); } S.done(cur);
    PG8_WAIT_V(0);
    if constexpr (!ALIGN_EPI) { if (wr == 0) PG8_BAR; }
    PG8_BAR;
#undef PG8_SA
#undef PG8_SB
#undef PG8_STAGE
#undef PG8_LDA
#undef PG8_LDB
#undef PG8_MMA
#undef PG8_WAIT_V
#undef PG8_WAIT_L
#undef PG8_BAR
#undef PG8_SCHED
#undef PG8_RELANE
}
}

#define XB_TMO      128
#define XB_XCNT(j)  (256  + 64 * (j))
#define XB_XSUB(j)  (1280 + 64 * (j))
#define XB_XGEN(j)  (2304 + 64 * (j))
#define XB_TOP      3328
#define XB_TOPGEN   3392
#define XCD_BAR_WORDS 3456
#define XB_SPIN_CAP (1u << 18)
__device__ __forceinline__ unsigned xb_ld(unsigned* p)              { return __hip_atomic_load(p, __ATOMIC_RELAXED, __HIP_MEMORY_SCOPE_AGENT); }
__device__ __forceinline__ unsigned xb_add(unsigned* p, unsigned v) { return __hip_atomic_fetch_add(p, v, __ATOMIC_RELAXED, __HIP_MEMORY_SCOPE_AGENT); }
__device__ __forceinline__ unsigned xb_xcc_id() { return (unsigned)__builtin_amdgcn_s_getreg((3 << 11) | 20) & 0xFu; }
#define XB_SPIN(cond, bar) do { unsigned _sp = 0; while (cond) { __builtin_amdgcn_s_sleep(1); \
    if ((++_sp & 255u) == 0u) { if (xb_ld(&(bar)[XB_TMO])) break; if (_sp > XB_SPIN_CAP) { atomicAdd(&(bar)[XB_TMO], 1u); break; } } } } while (0)
struct XcdBarrier { unsigned* bar; unsigned x; volatile LAS unsigned* st; };
__device__ __forceinline__ XcdBarrier xcd_barrier_post(unsigned* bar, volatile LAS unsigned* st) {
    XcdBarrier b; b.bar = bar; b.x = xb_xcc_id(); b.st = st;
    if (threadIdx.x == 0) (void)xb_add(&bar[XB_XCNT(b.x)], 1u);
    return b;
}
__device__ __forceinline__ void xcd_barrier_complete(unsigned* bar, unsigned x, unsigned& nloc, unsigned& nx) {
    const unsigned G = gridDim.x * gridDim.y * gridDim.z;
    unsigned sum, cnt, mine, sp = 0u;
    for (;;) {
        sum = 0u; cnt = 0u; mine = 0u;
#pragma unroll
        for (unsigned j = 0; j < 16; ++j) { const unsigned c = xb_ld(&bar[XB_XCNT(j)]); sum += c; cnt += (c > 0u) ? 1u : 0u; mine = (j == x) ? c : mine; }
        if (sum == G) break;
        __builtin_amdgcn_s_sleep(1);
        if ((++sp & 255u) == 0u) { if (xb_ld(&bar[XB_TMO])) break; if (sp > XB_SPIN_CAP) { atomicAdd(&bar[XB_TMO], 1u); break; } }
    }
    nloc = mine > 0u ? mine : 1u; nx = cnt > 0u ? cnt : 1u;
}
__device__ __forceinline__ void xcd_barrier(const XcdBarrier& b) {
    asm volatile("s_waitcnt vmcnt(0)" ::: "memory");
    __syncthreads();
    if (threadIdx.x == 0) {
        unsigned* bar = b.bar;
        __builtin_amdgcn_s_waitcnt(0);
        unsigned nloc = b.st[0], nx = b.st[1];
        if (nloc == 0u) { xcd_barrier_complete(bar, b.x, nloc, nx); b.st[0] = nloc; b.st[1] = nx; }
        const unsigned old = xb_add(&bar[XB_XSUB(b.x)], 1u);
        const unsigned gen = old / nloc;
        if (old + 1u == (gen + 1u) * nloc) {
            __builtin_amdgcn_fence(__ATOMIC_RELEASE, "agent");
            asm volatile("s_waitcnt vmcnt(0)" ::: "memory");
            const unsigned og = xb_add(&bar[XB_TOP], 1u);
            const unsigned tg = og / nx;
            if (og + 1u == (tg + 1u) * nx) xb_add(&bar[XB_TOPGEN], 1u);
            else XB_SPIN(xb_ld(&bar[XB_TOPGEN]) == tg, bar);
            __builtin_amdgcn_fence(__ATOMIC_ACQUIRE, "agent");
            xb_add(&bar[XB_XGEN(b.x)], 1u);
            asm volatile("s_waitcnt vmcnt(0)" ::: "memory");
        } else {
            XB_SPIN(xb_ld(&bar[XB_XGEN(b.x)]) == gen, bar);
            __builtin_amdgcn_fence(__ATOMIC_ACQUIRE, "agent");
            asm volatile("s_waitcnt vmcnt(0)" ::: "memory");
        }
    }
    __syncthreads();
}

struct Args { const float* in[35]; float* out; unsigned char* ws; int ph_lo, ph_hi; };
struct Frame {
    LAS unsigned char* lds; int tid, lane, wave, vcu, G;
    const float* const* in; float* out; unsigned char* ws;
};
#define WSP(T, off) ((GAS T*)(F.ws + (off)))
#define GIN(i) ((const GAS float*)F.in[i])
#define GOUT ((GAS float*)F.out)
__device__ __forceinline__ Frame launder(Frame P) {
    asm volatile("" : "+s"(P.ws), "+s"(P.out), "+s"(P.vcu), "+s"(P.G), "+s"(P.wave));
    unsigned lz; asm volatile("s_mov_b32 %0, 0" : "=s"(lz));
    int ln = (int)__builtin_amdgcn_mbcnt_hi(~0u, __builtin_amdgcn_mbcnt_lo(~0u, lz));
    P.lane = ln; P.tid = P.wave * 64 + ln;
    return P;
}
__device__ __forceinline__ int launder_s(int x) { asm volatile("" : "+s"(x)); return x; }
__device__ __forceinline__ int cond_of_panel(int pm) { return pm < 16 ? 0 : 1 + ((pm - 16) >> 2); }

struct SplitCtx { GAS float* slab; GAS unsigned* cnt; GAS unsigned* tmo; int nslab; };
typedef unsigned v4u_t __attribute__((ext_vector_type(4)));
__device__ __forceinline__ void split_count(const SplitCtx& sx, int r, int lane) {
    asm volatile("s_waitcnt vmcnt(0)" ::: "memory");
    if (lane == 0) __hip_atomic_fetch_add(sx.cnt + 64 * r, 1u, __ATOMIC_RELAXED, __HIP_MEMORY_SCOPE_AGENT);
}
__device__ __forceinline__ void split_wait(const SplitCtx& sx, int r, unsigned need, int wid) {
    if (wid == 0) {
        unsigned sp = 0;
        while ((unsigned)__builtin_amdgcn_readfirstlane((int)__hip_atomic_load(sx.cnt + 64 * r, __ATOMIC_RELAXED, __HIP_MEMORY_SCOPE_AGENT)) < need) {
            __builtin_amdgcn_s_sleep(2);
            if (++sp > (1u << 22)) { __hip_atomic_store(sx.tmo, 1u, __ATOMIC_RELAXED, __HIP_MEMORY_SCOPE_AGENT); break; } }
        __builtin_amdgcn_fence(__ATOMIC_ACQUIRE, "agent");
        asm volatile("s_waitcnt vmcnt(0)" ::: "memory");
    }
    asm volatile("" ::: "memory"); __builtin_amdgcn_s_barrier(); asm volatile("" ::: "memory");
}
__device__ __forceinline__ void split_publish(const SplitCtx& sx, const f32x4 (&acc)[2][2][4][2], const pg8::Unit& u, int wid, int lane) {
    const __amdgpu_buffer_rsrc_t rs = __builtin_amdgcn_make_buffer_rsrc((void*)(sx.slab + (size_t)(u.r * sx.nslab + u.part) * 65536), (short)0, 262144, 0x00020000);
    const int tb = (wid * 64 + lane) * 16;
#pragma unroll
    for (int ai = 0; ai < 2; ++ai)
#pragma unroll
        for (int bj = 0; bj < 2; ++bj)
#pragma unroll
            for (int m = 0; m < 4; ++m)
#pragma unroll
                for (int n = 0; n < 2; ++n) __builtin_amdgcn_raw_buffer_store_b128(__builtin_bit_cast(v4u_t, acc[ai][bj][m][n]), rs, tb, (((ai * 2 + bj) * 4 + m) * 2 + n) * 8192, 16);
    split_count(sx, u.r, lane);
}
template <bool PERM>
__device__ __forceinline__ void split_store(const SplitCtx& sx, const f32x4 (&acc)[2][2][4][2], const pg8::Unit& u, int npart, int wr, int wc, int fr, int fq) {
    GAS float* sl = sx.slab + (size_t)(u.r * npart + u.part) * 65536 + (wr * 64 + fr) * 256 + wc * 32 + (PERM ? 8 : 4) * fq;
#pragma unroll
    for (int ai = 0; ai < 2; ++ai)
#pragma unroll
        for (int m = 0; m < 4; ++m)
#pragma unroll
            for (int bj = 0; bj < 2; ++bj)
#pragma unroll
                for (int n = 0; n < 2; ++n) *(GAS f32x4*)(sl + (ai * 128 + m * 16) * 256 + bj * 128 + (PERM ? 4 : 16) * n) = acc[ai][bj][m][n];
}

struct EpiProj {
    static constexpr bool PERM = true, ACC_CHAIN = false;
    static constexpr int NSLAB = 0;
    GAS bf16* P; const GAS float* bias; SplitCtx sx; int f8;
    __device__ __forceinline__ void last(f32x4 (&acc)[2][2][4][2], const pg8::Unit& u, int wr, int wc, int fr, int fq, int wid, int lane) const { if ((u.role & 3) != 0) { split_store<PERM>(sx, acc, u, NSLAB + 1, wr, wc, fr, fq); return; } (*this)(acc, u, wr, wc, fr, fq, wid, lane); }
    __device__ __forceinline__ void operator()(const f32x4 (&acc)[2][2][4][2], const pg8::Unit& u, int wr, int wc, int fr, int fq, int wid, int lane) const {
        asm volatile("" : "+v"(fr), "+v"(fq), "+v"(lane));
        const int seg = f8 ? seg_of_g(u.pn >> 3) : seg_of_b(u.pn >> 3); const int act = (seg >= 9) ? 2 : ((seg == 1 || seg == 3 || seg == 4 || seg == 8) ? 1 : 0);
        const int row0 = u.pm * 256 + wr * 64 + fr, col0 = (u.pn & 7) * 256 + wc * 32 + 8 * fq, bcol0 = seg * 2048 + col0;
        GAS bf16* base = P + (size_t)seg * SEG_ELEMS; const float asc = f8 ? 1.f / W8_SCALE : 1.f;
        f32x4 bv[2][2];
#pragma unroll
        for (int bj = 0; bj < 2; ++bj)
#pragma unroll
            for (int n = 0; n < 2; ++n) bv[bj][n] = *(const GAS f32x4*)(bias + bcol0 + bj * 128 + 4 * n);
#pragma unroll
        for (int ai = 0; ai < 2; ++ai)
#pragma unroll
            for (int m = 0; m < 4; ++m) { GAS bf16* rowp = base + (size_t)(row0 + ai * 128 + m * 16) * WB + col0;
#pragma unroll
                for (int bj = 0; bj < 2; ++bj) { f32x4 v0 = acc[ai][bj][m][0] * asc + bv[bj][0], v1 = acc[ai][bj][m][1] * asc + bv[bj][1];
                    if (act == 1) {
#pragma unroll
                        for (int j = 0; j < 4; ++j) { v0[j] = siluf(v0[j]); v1[j] = siluf(v1[j]); } }
                    else if (act == 2) {
#pragma unroll
                        for (int j = 0; j < 4; ++j) { v0[j] = sigm(v0[j]); v1[j] = sigm(v1[j]); } }
                    u32x4 w; w.x = cvt_pk_bf16(v0[0], v0[1]); w.y = cvt_pk_bf16(v0[2], v0[3]); w.z = cvt_pk_bf16(v1[0], v1[1]); w.w = cvt_pk_bf16(v1[2], v1[3]);
                    *(GAS u32x4*)(rowp + bj * 128) = w; } }
    }
};
struct EpiGlu {
    static constexpr bool PERM = true, ACC_CHAIN = false;
    static constexpr int NSLAB = 0;
    const GAS bf16* YAP; const GAS bf16* GA; GAS bf16* YA; const GAS float* bias; SplitCtx sx;
    __device__ __forceinline__ void last(f32x4 (&acc)[2][2][4][2], const pg8::Unit& u, int wr, int wc, int fr, int fq, int wid, int lane) const { (*this)(acc, u, wr, wc, fr, fq, wid, lane); }
    __device__ __forceinline__ void operator()(const f32x4 (&acc)[2][2][4][2], const pg8::Unit& u, int wr, int wc, int fr, int fq, int wid, int lane) const {
        asm volatile("" : "+v"(fr), "+v"(fq), "+v"(lane));
        const int row0 = u.pm * 256 + wr * 64 + fr, col0 = u.pn * 256 + wc * 32 + 8 * fq;
        f32x4 bv[2][2];
#pragma unroll
        for (int bj = 0; bj < 2; ++bj)
#pragma unroll
            for (int n = 0; n < 2; ++n) bv[bj][n] = *(const GAS f32x4*)(bias + col0 + bj * 128 + 4 * n);
#pragma unroll
        for (int ai = 0; ai < 2; ++ai)
#pragma unroll
            for (int m = 0; m < 4; ++m) { const size_t ro = (size_t)(row0 + ai * 128 + m * 16) * WB + col0;
#pragma unroll
                for (int bj = 0; bj < 2; ++bj) { const f32x4 v0 = acc[ai][bj][m][0] * (1.f / W8_SCALE) + bv[bj][0], v1 = acc[ai][bj][m][1] * (1.f / W8_SCALE) + bv[bj][1];
                    const u32x4 yv = *(const GAS u32x4*)(YAP + ro + bj * 128), gv = *(const GAS u32x4*)(GA + ro + bj * 128);
                    float o[8];
                    o[0] = bflo(yv.x) * sigm(v0[0]) * bflo(gv.x); o[1] = bfhi(yv.x) * sigm(v0[1]) * bfhi(gv.x);
                    o[2] = bflo(yv.y) * sigm(v0[2]) * bflo(gv.y); o[3] = bfhi(yv.y) * sigm(v0[3]) * bfhi(gv.y);
                    o[4] = bflo(yv.z) * sigm(v1[0]) * bflo(gv.z); o[5] = bfhi(yv.z) * sigm(v1[1]) * bfhi(gv.z);
                    o[6] = bflo(yv.w) * sigm(v1[2]) * bflo(gv.w); o[7] = bfhi(yv.w) * sigm(v1[3]) * bfhi(gv.w);
                    u32x4 w; w.x = cvt_pk_bf16(o[0], o[1]); w.y = cvt_pk_bf16(o[2], o[3]); w.z = cvt_pk_bf16(o[4], o[5]); w.w = cvt_pk_bf16(o[6], o[7]);
                    *(GAS u32x4*)(YA + ro + bj * 128) = w; } }
    }
};
struct EpiMerge {
    static constexpr bool PERM = true, ACC_CHAIN = true;
    const GAS bf16* PROJ; GAS bf16* MG; SplitCtx sx;
    __device__ __forceinline__ void last(f32x4 (&acc)[2][2][4][2], const pg8::Unit& u, int wr, int wc, int fr, int fq, int wid, int lane) const { (*this)(acc, u, wr, wc, fr, fq, wid, lane); }
    __device__ __forceinline__ void operator()(f32x4 (&acc)[2][2][4][2], const pg8::Unit& u, int wr, int wc, int fr, int fq, int wid, int lane) const {
        asm volatile("" : "+v"(fr), "+v"(fq), "+v"(lane));
        const int br = u.pm / 24, pm = u.pm - br * 24, pn = u.pn - br * 16;
        const int role = u.role & 3; const bool last = (u.role & pg8::U_LAST) != 0;
        const int lrow0 = wr * 64 + fr, lcol0 = wc * 32 + 8 * fq;
        const int row0 = pm * 256 + lrow0, col0 = pn * 256 + lcol0;
        const GAS bf16* sg = PROJ + (size_t)(9 + 2 * br + (col0 >> 11)) * SEG_ELEMS + (col0 & 2047);
        const GAS bf16* sn = sg + (last ? 0 : 2) * SEG_ELEMS;
        const __amdgpu_buffer_rsrc_t rs = __builtin_amdgcn_make_buffer_rsrc((void*)(sx.slab + (size_t)u.r * 65536), (short)0, 262144, 0x00020000);
        if (role == pg8::U_OWN && last) split_wait(sx, u.r, 8u, wid);
        const int so_v = (lrow0 * 256 + lcol0) * 4;
        if (!last) {
#pragma unroll
            for (int ai = 0; ai < 2; ++ai)
#pragma unroll
                for (int m = 0; m < 4; ++m) { const int row = row0 + ai * 128 + m * 16;
#pragma unroll
                    for (int bj = 0; bj < 2; ++bj) {
                        const u32x4 sv = *(const GAS u32x4*)(sg + (size_t)row * WB + bj * 128), nv = *(const GAS u32x4*)(sn + (size_t)row * WB + bj * 128);
                        f32x4 d0 = {bflo(nv.x), bfhi(nv.x), bflo(nv.y), bfhi(nv.y)}, d1 = {bflo(nv.z), bfhi(nv.z), bflo(nv.w), bfhi(nv.w)};
                        const f32x4 g0 = {bflo(sv.x), bfhi(sv.x), bflo(sv.y), bfhi(sv.y)}, g1 = {bflo(sv.z), bfhi(sv.z), bflo(sv.w), bfhi(sv.w)};
#pragma unroll
                        for (int e = 0; e < 4; ++e) { d0[e] = g0[e] * frcp(fmaxf(d0[e], 1e-12f)); d1[e] = g1[e] * frcp(fmaxf(d1[e], 1e-12f)); }
                        acc[ai][bj][m][0] *= d0; acc[ai][bj][m][1] *= d1; } }
        } else {
#pragma unroll
            for (int ai = 0; ai < 2; ++ai)
#pragma unroll
                for (int m = 0; m < 4; ++m) { const int lr = ai * 128 + m * 16; const int row = row0 + lr;
#pragma unroll
                    for (int bj = 0; bj < 2; ++bj) {
                        const u32x4 sv = *(const GAS u32x4*)(sg + (size_t)row * WB + bj * 128);
                        const f32x4 g0 = {bflo(sv.x), bfhi(sv.x), bflo(sv.y), bfhi(sv.y)}, g1 = {bflo(sv.z), bfhi(sv.z), bflo(sv.w), bfhi(sv.w)};
                        const int so_s = (lr * 256 + bj * 128) * 4;
                        f32x4 v0 = acc[ai][bj][m][0] * g0, v1 = acc[ai][bj][m][1] * g1;
                        if (role == pg8::U_PUB) { __builtin_amdgcn_raw_buffer_store_b128(__builtin_bit_cast(v4u_t, v0), rs, so_v, so_s, 16); __builtin_amdgcn_raw_buffer_store_b128(__builtin_bit_cast(v4u_t, v1), rs, so_v, so_s + 16, 16); }
                        else { if (role == pg8::U_OWN) { v0 += __builtin_bit_cast(f32x4, __builtin_amdgcn_raw_buffer_load_b128(rs, so_v, so_s, 16)); v1 += __builtin_bit_cast(f32x4, __builtin_amdgcn_raw_buffer_load_b128(rs, so_v, so_s + 16, 16)); }
                            u32x4 w; w.x = cvt_pk_bf16(v0[0], v0[1]); w.y = cvt_pk_bf16(v0[2], v0[3]); w.z = cvt_pk_bf16(v1[0], v1[1]); w.w = cvt_pk_bf16(v1[2], v1[3]);
                            *(GAS u32x4*)(MG + (size_t)row * D + col0 + bj * 128) = w; }
                        acc[ai][bj][m][0] = (f32x4){0.f, 0.f, 0.f, 0.f}; acc[ai][bj][m][1] = (f32x4){0.f, 0.f, 0.f, 0.f}; } }
        }
        if (role == pg8::U_PUB && last) split_count(sx, u.r, lane);
    }
};
struct EpiOut {
    static constexpr bool PERM = true, ACC_CHAIN = false;
    static constexpr int NSLAB = 1;
    const GAS float* bias; const GAS float* mod; GAS bf16* U; SplitCtx sx;
    __device__ __forceinline__ void last(f32x4 (&acc)[2][2][4][2], const pg8::Unit& u, int wr, int wc, int fr, int fq, int wid, int lane) const {
        const int role = u.role & 3;
        if (role == 0) { (*this)(acc, u, wr, wc, fr, fq, wid, lane); return; }
        asm volatile("" : "+v"(fr), "+v"(fq), "+v"(lane));
        const int lrow0 = wr * 64 + fr, lcol0 = wc * 32 + 8 * fq, so_v = (lrow0 * 256 + lcol0) * 4;
        const __amdgpu_buffer_rsrc_t rs = __builtin_amdgcn_make_buffer_rsrc((void*)(sx.slab + (size_t)u.r * 65536), (short)0, 262144, 0x00020000);
        if (role == pg8::U_PUB) {
#pragma unroll
            for (int ai = 0; ai < 2; ++ai)
#pragma unroll
                for (int m = 0; m < 4; ++m)
#pragma unroll
                    for (int bj = 0; bj < 2; ++bj) { const int so_s = ((ai * 128 + m * 16) * 256 + bj * 128) * 4;
                        __builtin_amdgcn_raw_buffer_store_b128(__builtin_bit_cast(v4u_t, acc[ai][bj][m][0]), rs, so_v, so_s, 16); __builtin_amdgcn_raw_buffer_store_b128(__builtin_bit_cast(v4u_t, acc[ai][bj][m][1]), rs, so_v, so_s + 16, 16); }
            split_count(sx, u.r, lane); return; }
        split_wait(sx, u.r, 8u, wid);
        const int row0 = u.pm * 256 + lrow0, col0 = u.pn * 256 + lcol0;
        const GAS float* gate = mod + (size_t)cond_of_panel(u.pm) * 12288 + 8192;
        f32x4 bv[2][2], gv[2][2];
#pragma unroll
        for (int bj = 0; bj < 2; ++bj)
#pragma unroll
            for (int n = 0; n < 2; ++n) { bv[bj][n] = *(const GAS f32x4*)(bias + col0 + bj * 128 + 4 * n); gv[bj][n] = *(const GAS f32x4*)(gate + col0 + bj * 128 + 4 * n); }
#pragma unroll
        for (int ai = 0; ai < 2; ++ai)
#pragma unroll
            for (int m = 0; m < 4; ++m) { GAS bf16* rowp = U + (size_t)(row0 + ai * 128 + m * 16) * D + col0;
#pragma unroll
                for (int bj = 0; bj < 2; ++bj) { const int so_s = ((ai * 128 + m * 16) * 256 + bj * 128) * 4;
                    const f32x4 p0 = __builtin_bit_cast(f32x4, __builtin_amdgcn_raw_buffer_load_b128(rs, so_v, so_s, 16)), p1 = __builtin_bit_cast(f32x4, __builtin_amdgcn_raw_buffer_load_b128(rs, so_v, so_s + 16, 16));
                    const f32x4 v0 = gv[bj][0] * (acc[ai][bj][m][0] + p0 + bv[bj][0]), v1 = gv[bj][1] * (acc[ai][bj][m][1] + p1 + bv[bj][1]);
                    u32x4 w; w.x = cvt_pk_bf16(v0[0], v0[1]); w.y = cvt_pk_bf16(v0[2], v0[3]); w.z = cvt_pk_bf16(v1[0], v1[1]); w.w = cvt_pk_bf16(v1[2], v1[3]);
                    *(GAS u32x4*)(rowp + bj * 128) = w; } }
    }
    __device__ __forceinline__ void operator()(const f32x4 (&acc)[2][2][4][2], const pg8::Unit& u, int wr, int wc, int fr, int fq, int wid, int lane) const {
        asm volatile("" : "+v"(fr), "+v"(fq), "+v"(lane));
        const int row0 = u.pm * 256 + wr * 64 + fr, col0 = u.pn * 256 + wc * 32 + 8 * fq;
        const GAS float* gate = mod + (size_t)cond_of_panel(u.pm) * 12288 + 8192;
        f32x4 bv[2][2], gv[2][2];
#pragma unroll
        for (int bj = 0; bj < 2; ++bj)
#pragma unroll
            for (int n = 0; n < 2; ++n) { bv[bj][n] = *(const GAS f32x4*)(bias + col0 + bj * 128 + 4 * n); gv[bj][n] = *(const GAS f32x4*)(gate + col0 + bj * 128 + 4 * n); }
#pragma unroll
        for (int ai = 0; ai < 2; ++ai)
#pragma unroll
            for (int m = 0; m < 4; ++m) { GAS bf16* rowp = U + (size_t)(row0 + ai * 128 + m * 16) * D + col0;
#pragma unroll
                for (int bj = 0; bj < 2; ++bj) { const f32x4 v0 = gv[bj][0] * (acc[ai][bj][m][0] + bv[bj][0]), v1 = gv[bj][1] * (acc[ai][bj][m][1] + bv[bj][1]);
                    u32x4 w; w.x = cvt_pk_bf16(v0[0], v0[1]); w.y = cvt_pk_bf16(v0[2], v0[3]); w.z = cvt_pk_bf16(v1[0], v1[1]); w.w = cvt_pk_bf16(v1[2], v1[3]);
                    *(GAS u32x4*)(rowp + bj * 128) = w; } }
    }
};

struct P0Item { const GAS float* W; GAS bf16* WT; int K, N, item, win; };
__device__ __forceinline__ void p0_load(const P0Item& d, float (&rg)[32], int lane) {
    const int nblk = d.N / 32, kb = d.item / nblk, nb = d.item % nblk, k0 = 64 * kb, n0 = 32 * nb;
    const GAS float* p = d.W + (size_t)(k0 + (lane >> 5)) * d.N + n0 + (lane & 31);
#pragma unroll
    for (int i = 0; i < 32; ++i) rg[i] = __builtin_nontemporal_load(p + (size_t)(2 * i) * d.N);
}
__device__ __forceinline__ void p0_finish(const P0Item& d, const float (&rg)[32], LAS float* scr, int lane) {
    const int nblk = d.N / 32, kb = d.item / nblk, nb = d.item % nblk, k0 = 64 * kb, n0 = 32 * nb;
#pragma unroll
    for (int i = 0; i < 32; ++i) scr[(2 * i + (lane >> 5)) * 33 + (lane & 31)] = rg[i];
    LDS_WAIT(); asm volatile("" ::: "memory");
    const int c = lane & 7;
    const int seg = n0 >> 11; const bool f8 = (d.win == 1 && seg_is_fp8(seg)) || d.win == 2;
    const int rbase = d.win == 1 ? seg_local(seg) * 2048 + (n0 & 2047) : n0;
#pragma unroll
    for (int j = 0; j < 4; ++j) { const int n = (lane >> 3) + 8 * j; const LAS float* s = scr + (8 * c) * 33 + n;
        if (!f8) { u32x4 o; o.x = cvt_pk_bf16(s[0 * 33], s[1 * 33]); o.y = cvt_pk_bf16(s[2 * 33], s[3 * 33]); o.z = cvt_pk_bf16(s[4 * 33], s[5 * 33]); o.w = cvt_pk_bf16(s[6 * 33], s[7 * 33]);
            __builtin_nontemporal_store(o, (GAS u32x4*)(d.WT + (size_t)(rbase + n) * d.K + k0 + 8 * c)); }
        else { int w0 = 0, w1 = 0;
#define P0_F8(i) __builtin_amdgcn_fmed3f(s[(i) * 33] * W8_SCALE, -448.f, 448.f)
            w0 = __builtin_amdgcn_cvt_pk_fp8_f32(P0_F8(0), P0_F8(1), w0, false); w0 = __builtin_amdgcn_cvt_pk_fp8_f32(P0_F8(2), P0_F8(3), w0, true);
            w1 = __builtin_amdgcn_cvt_pk_fp8_f32(P0_F8(4), P0_F8(5), w1, false); w1 = __builtin_amdgcn_cvt_pk_fp8_f32(P0_F8(6), P0_F8(7), w1, true);
#undef P0_F8
            u32x2 o; o.x = (unsigned)w0; o.y = (unsigned)w1;
            __builtin_nontemporal_store(o, (GAS u32x2*)((GAS unsigned char*)d.WT + (d.win == 1 ? 144 * MiB : 0) + (size_t)(rbase + n) * d.K + k0 + 8 * c)); } }
    LDS_WAIT(); asm volatile("" ::: "memory");
}
constexpr int P0_I_IN = 64 * 960, P0_I_GLU = 32 * 64, P0_I_BR = 32 * 128, P0_I_OUT = 64 * 128, P0_I_LRU = 8;
constexpr int P0_PER_LAYER = P0_I_IN + P0_I_GLU + 3 * P0_I_BR + P0_I_OUT + 64 * P0_I_LRU;
__device__ __forceinline__ P0Item p0_desc(const Frame& F, int it) {
    const int l = it / P0_PER_LAYER; int r = it - l * P0_PER_LAYER;
    if (r < P0_I_IN) return P0Item{GIN(9) + (size_t)l * D * INC, WSP(bf16, WS_WIN) + (size_t)l * INC * D, D, INC, r, 1}; r -= P0_I_IN;
    if (r < P0_I_GLU) return P0Item{GIN(19) + (size_t)l * WB * WB, WSP(bf16, WS_WGLU) + (size_t)l * WB * WB, WB, WB, r, 2}; r -= P0_I_GLU;
    if (r < 3 * P0_I_BR) { const int b = r / P0_I_BR; return P0Item{GIN(30) + (size_t)(l * 3 + b) * WB * D, WSP(bf16, WS_WBR) + (size_t)(l * 3 + b) * D * WB, WB, D, r - b * P0_I_BR, 0}; } r -= 3 * P0_I_BR;
    if (r < P0_I_OUT) return P0Item{GIN(31) + (size_t)l * D * D, WSP(bf16, WS_WOUT) + (size_t)l * D * D, D, D, r, 0}; r -= P0_I_OUT;
    const int mi = r / P0_I_LRU, sub = r - mi * P0_I_LRU;
    const int dr = mi >> 5, mat = (mi >> 4) & 1, n = mi & 15;
    return P0Item{(mat ? GIN(25) : GIN(23)) + (size_t)((l * 2 + dr) * 16 + n) * 16384, WSP(bf16, WS_WLRU) + (size_t)(l * 64 + mi) * 16384, 128, 128, sub, 0};
}
__device__ __forceinline__ void p0_prologue(const Frame& F) {
    if (F.vcu < 96) {
        const int l = F.vcu / 48, j0 = (F.vcu % 48) * 256;
        LAS float* sc = (LAS float*)F.lds;
        LAS float* red = (LAS float*)(F.lds + 49152);
        for (int i = F.tid; i < 3 * 4096; i += 512) { const int c = i >> 12, k = i & 4095; const float v = c == 0 ? GIN(6)[k] : GIN(5)[(c - 1) * 4096 + k]; sc[i] = siluf(v); }
        __syncthreads();
        const GAS float* W = GIN(7) + (size_t)l * 4096 * 12288 + j0 + 4 * F.lane;
        f32x4 a0 = {0.f, 0.f, 0.f, 0.f}, a1 = a0, a2 = a0;
        const int i0 = F.wave * 512;
#pragma unroll 8
        for (int i = i0; i < i0 + 512; ++i) { const f32x4 w = *(const GAS f32x4*)(W + (size_t)i * 12288); a0 += sc[i] * w; a1 += sc[4096 + i] * w; a2 += sc[8192 + i] * w; }
        *(LAS f32x4*)(red + (F.wave * 3 + 0) * 256 + 4 * F.lane) = a0; *(LAS f32x4*)(red + (F.wave * 3 + 1) * 256 + 4 * F.lane) = a1; *(LAS f32x4*)(red + (F.wave * 3 + 2) * 256 + 4 * F.lane) = a2;
        __syncthreads();
        for (int o = F.tid; o < 768; o += 512) { const int c = o >> 8, j = o & 255; float s = GIN(8)[l * 12288 + j0 + j];
#pragma unroll
            for (int w = 0; w < 8; ++w) s += red[(w * 3 + c) * 256 + j];
            WSP(float, WS_MOD)[(l * 3 + c) * 12288 + j0 + j] = s; }
        __syncthreads();
    }
    LAS float* scr = (LAS float*)(F.lds + F.wave * 16384);
    const int gw = F.vcu * 8 + F.wave, NGW = F.G * 8;
    constexpr int T = 2 * P0_PER_LAYER, P0_SKIP = 6; const int GVW = 96 * 8;
    const int NR = NGW > GVW ? (T / NGW > P0_SKIP ? T / NGW - P0_SKIP : 0) : T / NGW + 1;
#define P0_ITEM_AT(k) ((k) < NR ? gw + (k) * NGW : (gw < GVW ? T : NR * NGW + (gw - GVW) + ((k) - NR) * (NGW - GVW)))
    if (P0_ITEM_AT(0) < T) {
        P0Item cur = p0_desc(F, P0_ITEM_AT(0)); float rc[32]; p0_load(cur, rc, F.lane);
        for (int k = 0; P0_ITEM_AT(k) < T; ++k) {
            const int itn = P0_ITEM_AT(k + 1); const bool has = itn < T;
            P0Item nxt = cur; float rn[32];
            if (has) { nxt = p0_desc(F, itn); p0_load(nxt, rn, F.lane); }
            else {
#pragma unroll
                for (int i = 0; i < 32; ++i) rn[i] = 0.f; }
            p0_finish(cur, rc, scr, F.lane);
            cur = nxt;
#pragma unroll
            for (int i = 0; i < 32; ++i) rc[i] = rn[i];
        }
    }
#undef P0_ITEM_AT
    __syncthreads();
}

template <int MODE>
__device__ __forceinline__ void ln_phase(const Frame& F, int l) {
    const int gw = F.vcu * 8 + F.wave, NGW = F.G * 8;
    const GAS float* modl = WSP(float, WS_MOD) + (size_t)l * 3 * 12288;
    for (int m = gw; m < NTOK; m += NGW) {
        const GAS float* src = (m < NCTX ? GIN(0) + (size_t)m * D : GIN(1) + (size_t)(m - NCTX) * D);
        GAS bf16* x1row = WSP(bf16, WS_X1) + (size_t)m * D;
        const GAS bf16* usrc = WSP(bf16, WS_V) + (size_t)m * D;
        f32x4 v[16]; float s = 0.f;
#pragma unroll
        for (int j = 0; j < 16; ++j) {
            if (MODE == 2) { const u32x2 xw = *(const GAS u32x2*)(x1row + 256 * j + 4 * F.lane); v[j] = (f32x4){bflo(xw.x), bfhi(xw.x), bflo(xw.y), bfhi(xw.y)}; }
            else v[j] = *(const GAS f32x4*)(src + 256 * j + 4 * F.lane);
            if (MODE != 0) { const u32x2 uw = *(const GAS u32x2*)(usrc + 256 * j + 4 * F.lane); v[j] = DN_ALPHA * v[j] + (f32x4){bflo(uw.x), bfhi(uw.x), bflo(uw.y), bfhi(uw.y)}; }
            s += (v[j][0] + v[j][1]) + (v[j][2] + v[j][3]); }
        float mean = wave_sum(s, F.lane) * (1.f / D), s2 = 0.f;
#pragma unroll
        for (int j = 0; j < 16; ++j) { v[j] = v[j] - mean; s2 += (v[j][0] * v[j][0] + v[j][1] * v[j][1]) + (v[j][2] * v[j][2] + v[j][3] * v[j][3]); }
        float rstd = 1.f / sqrtf(wave_sum(s2, F.lane) * (1.f / D) + LN_EPS);
        if (MODE != 0) {
            const GAS float* g = GIN(33) + (size_t)(MODE == 1 ? l - 1 : l) * D; const GAS float* b = GIN(34) + (size_t)(MODE == 1 ? l - 1 : l) * D;
            GAS float* dst = GOUT + (size_t)m * D;
            s = 0.f;
#pragma unroll
            for (int j = 0; j < 16; ++j) { const f32x4 gg = *(const GAS f32x4*)(g + 256 * j + 4 * F.lane), bb = *(const GAS f32x4*)(b + 256 * j + 4 * F.lane);
                v[j] = v[j] * rstd * gg + bb;
                if (MODE == 1) { u32x2 xw; xw.x = cvt_pk_bf16(v[j][0], v[j][1]); xw.y = cvt_pk_bf16(v[j][2], v[j][3]); *(GAS u32x2*)(x1row + 256 * j + 4 * F.lane) = xw; }
                else __builtin_nontemporal_store(v[j], (GAS f32x4*)(dst + 256 * j + 4 * F.lane));
                s += (v[j][0] + v[j][1]) + (v[j][2] + v[j][3]); }
            if (MODE == 2) continue;
            mean = wave_sum(s, F.lane) * (1.f / D); s2 = 0.f;
#pragma unroll
            for (int j = 0; j < 16; ++j) { v[j] = v[j] - mean; s2 += (v[j][0] * v[j][0] + v[j][1] * v[j][1]) + (v[j][2] * v[j][2] + v[j][3] * v[j][3]); }
            rstd = 1.f / sqrtf(wave_sum(s2, F.lane) * (1.f / D) + LN_EPS);
        }
        const GAS float* md = modl + (size_t)(m < NCTX ? 0 : 1 + ((m - NCTX) >> 10)) * 12288;
        GAS bf16* hrow = WSP(bf16, WS_H) + (size_t)m * D;
#pragma unroll
        for (int j = 0; j < 16; ++j) { const f32x4 sh = *(const GAS f32x4*)(md + 256 * j + 4 * F.lane), scl = *(const GAS f32x4*)(md + 4096 + 256 * j + 4 * F.lane);
            const f32x4 h = v[j] * rstd * (1.f + scl) + sh; u32x2 w; w.x = cvt_pk_bf16(h[0], h[1]); w.y = cvt_pk_bf16(h[2], h[3]);
            *(GAS u32x2*)(hrow + 256 * j + 4 * F.lane) = w;
            int w8 = 0;
            w8 = __builtin_amdgcn_cvt_pk_fp8_f32(__builtin_amdgcn_fmed3f(h[0], -448.f, 448.f), __builtin_amdgcn_fmed3f(h[1], -448.f, 448.f), w8, false);
            w8 = __builtin_amdgcn_cvt_pk_fp8_f32(__builtin_amdgcn_fmed3f(h[2], -448.f, 448.f), __builtin_amdgcn_fmed3f(h[3], -448.f, 448.f), w8, true);
            *(GAS unsigned*)(WSP(unsigned char, WS_TMP) + (size_t)m * D + 256 * j + 4 * F.lane) = (unsigned)w8; }
    }
}

__device__ __forceinline__ void s5_coef(const GAS float* are, const GAS float* aim, float dt, int p, float& lr, float& li, float& zr, float& zi) {
    const float ar = fminf(are[p], -1e-4f), ai = aim[p];
    const float mag = expf(dt * ar); float sn, cs; sincosf(dt * ai, &sn, &cs);
    lr = mag * cs; li = mag * sn;
    const float den = ar * ar + ai * ai;
    zr = ((lr - 1.f) * ar + li * ai) / den; zi = (li * ar - (lr - 1.f) * ai) / den;
}
__device__ __forceinline__ void s5_item(const Frame& F, int l, int sq, int g, int dr, LAS unsigned char* wl) {
    const int lane = F.lane, r = lane & 15, q = lane >> 4;
    const bool lat = sq >= 16; const int L = lat ? 1024 : 256, mbase = lat ? NCTX + (sq - 16) * 1024 : sq * 256;
    LAS float* XS = (LAS float*)wl;
    LAS bf16* HS = (LAS bf16*)(wl + 8448);
    const GAS float* are = GIN(11) + (size_t)((l * 2 + dr) * 128 + g) * 64; const GAS float* aim = GIN(12) + (size_t)((l * 2 + dr) * 128 + g) * 64;
    const float dt = expf(GIN(13)[(l * 2 + dr) * 128 + g]);
    float lr, li, zr0, zi0; s5_coef(are, aim, dt, lane, lr, li, zr0, zi0);
    bf16x8 bzf[8];
#pragma unroll
    for (int nt = 0; nt < 8; ++nt) {
        const int pp = 8 * nt + (r >> 1); float a_, b_, zr, zi; s5_coef(are, aim, dt, pp, a_, b_, zr, zi);
        u32x4 w = {0u, 0u, 0u, 0u};
        if (q < 2) {
            const GAS float* pbr = GIN(14) + ((size_t)(l * 128 + g) * 64 + pp) * 16 + 8 * q; const GAS float* pbi = GIN(15) + ((size_t)(l * 128 + g) * 64 + pp) * 16 + 8 * q;
            const f32x4 r0 = *(const GAS f32x4*)pbr, r1 = *(const GAS f32x4*)(pbr + 4), i0 = *(const GAS f32x4*)pbi, i1 = *(const GAS f32x4*)(pbi + 4);
            const bool im = (r & 1) != 0;
            const f32x4 x0 = im ? zr * i0 + zi * r0 : zr * r0 - zi * i0, x1 = im ? zr * i1 + zi * r1 : zr * r1 - zi * i1;
            w.x = cvt_pk_bf16(x0[0], x0[1]); w.y = cvt_pk_bf16(x0[2], x0[3]); w.z = cvt_pk_bf16(x1[0], x1[1]); w.w = cvt_pk_bf16(x1[2], x1[3]);
        }
        bzf[nt] = __builtin_bit_cast(bf16x8, w);
    }
    bf16x8 cmf[4];
#pragma unroll
    for (int ks = 0; ks < 4; ++ks) {
        const int p0 = 16 * ks + 4 * q;
        const f32x4 cr = *(const GAS f32x4*)(GIN(16) + ((size_t)(l * 128 + g) * 16 + r) * 64 + p0), ci = *(const GAS f32x4*)(GIN(17) + ((size_t)(l * 128 + g) * 16 + r) * 64 + p0);
        u32x4 w; w.x = cvt_pk_bf16(cr[0], -ci[0]); w.y = cvt_pk_bf16(cr[1], -ci[1]); w.z = cvt_pk_bf16(cr[2], -ci[2]); w.w = cvt_pk_bf16(cr[3], -ci[3]);
        cmf[ks] = __builtin_bit_cast(bf16x8, w);
    }
    float hr = 0.f, hi = 0.f;
    if (lat) { const GAS float* st = GIN(2) + ((size_t)(((sq - 16) * 2 + l) * 2 + dr) * 128 + g) * 128 + 2 * lane; hr = st[0]; hi = st[1]; }
    const GAS bf16* UA = WSP(bf16, WS_PROJ);
    GAS bf16* YS = WSP(bf16, WS_YS5) + (size_t)dr * SEG_ELEMS;
    const int nch = L / 16;
    u32x4 uq[4] = {{0u, 0u, 0u, 0u}, {0u, 0u, 0u, 0u}, {0u, 0u, 0u, 0u}, {0u, 0u, 0u, 0u}};
#define S5_ULOAD(cc_) (*(const GAS u32x4*)(UA + (size_t)(mbase + 16 * (dr ? nch - 1 - (cc_) : (cc_)) + r) * WB + 16 * g + 8 * q))
    if (q < 2) {
#pragma unroll
        for (int k = 0; k < 4; ++k) uq[k] = S5_ULOAD(k); }
    for (int cc = 0; cc < nch; ++cc) {
        const int t0 = 16 * (dr ? nch - 1 - cc : cc);
        const bf16x8 uf = __builtin_bit_cast(bf16x8, uq[0]);
        uq[0] = uq[1]; uq[1] = uq[2]; uq[2] = uq[3];
        if (q < 2 && cc + 4 < nch) uq[3] = S5_ULOAD(cc + 4);
#pragma unroll
        for (int nt = 0; nt < 8; ++nt) { const f32x4 x = __builtin_amdgcn_mfma_f32_16x16x32_bf16(bzf[nt], uf, (f32x4){0.f, 0.f, 0.f, 0.f}, 0, 0, 0);
            *(LAS f32x4*)(XS + r * 132 + 16 * nt + 4 * q) = x; }
        LDS_WAIT();
#pragma unroll 4
        for (int s = 0; s < 16; ++s) { const int tt = dr ? 15 - s : s;
            const f32x2 x2 = *(const LAS f32x2*)(XS + tt * 132 + 2 * lane);
            const float nr = lr * hr - li * hi + x2[0], ni = lr * hi + li * hr + x2[1]; hr = nr; hi = ni;
            ((LAS unsigned*)HS)[tt * 68 + lane] = cvt_pk_bf16(nr, ni); }
        LDS_WAIT();
        f32x4 y = {0.f, 0.f, 0.f, 0.f};
#pragma unroll
        for (int ks = 0; ks < 4; ++ks) { const bf16x8 hf = *(const LAS bf16x8*)(HS + r * 136 + 32 * ks + 8 * q); y = __builtin_amdgcn_mfma_f32_16x16x32_bf16(cmf[ks], hf, y, 0, 0, 0); }
        { u32x2 yw; yw.x = cvt_pk_bf16(y[0], y[1]); yw.y = cvt_pk_bf16(y[2], y[3]); *(GAS u32x2*)(YS + (size_t)(mbase + t0 + r) * WB + 16 * g + 4 * q) = yw; }
        LDS_WAIT();
    }
    if (!lat) { GAS float* st = GOUT + 25165824 + ((size_t)((sq * 2 + l) * 2 + dr) * 128 + g) * 128 + 2 * lane; st[0] = hr; st[1] = hi; }
#undef S5_ULOAD
}
__device__ __forceinline__ void s5_wg_unit(const Frame& F, int l, int u) {
    LAS unsigned char* wl = F.lds + F.wave * 12800;
    if (u < 64) { const int idx = u * 8 + F.wave; s5_item(F, l, 16 + (idx >> 8), (idx >> 1) & 127, idx & 1, wl); }
    else for (int k = 0; k < 4; ++k) { const int id = (u - 64) * 32 + F.wave * 4 + k; s5_item(F, l, id >> 8, (id >> 1) & 127, id & 1, wl); }
}

__device__ __forceinline__ float neg_expm1(float x) {
    if (x > -0.3f) return -x * (1.f + x * (0.5f + x * (0.16666667f + x * (0.041666668f + x * 0.0083333338f))));
    return 1.f - __expf(x);
}
__device__ __forceinline__ void lru_unit(const Frame& F, int l, int sq, int n, int dr) {
    const int lane = F.lane, r = lane & 15, q = lane >> 4, w = F.wave;
    const bool lat = sq >= 16; const int L = lat ? 1024 : 256, mbase = lat ? NCTX + (sq - 16) * 1024 : sq * 256, npan = L / 256;
    LAS bf16* XC = (LAS bf16*)F.lds;
    const int d = 16 * w + r, ch = 128 * n + d;
    const GAS bf16* wta = WSP(bf16, WS_WLRU) + ((size_t)(l * 64 + (dr * 2 + 0) * 16 + n) * 128 + d) * 128;
    const GAS bf16* wtx = WSP(bf16, WS_WLRU) + ((size_t)(l * 64 + (dr * 2 + 1) * 16 + n) * 128 + d) * 128;
    bf16x8 wa[4], wx[4];
#pragma unroll
    for (int ks = 0; ks < 4; ++ks) { wa[ks] = *(const bf16x8*)(wta + 32 * ks + 8 * q); wx[ks] = *(const bf16x8*)(wtx + 32 * ks + 8 * q); }
    const float ba = GIN(24)[(l * 2 + dr) * WB + ch], bx = GIN(26)[(l * 2 + dr) * WB + ch], lamv = GIN(27)[(l * 2 + dr) * WB + ch];
    const float e1 = expf(-fabsf(lamv)), u1 = 1.f + e1, l1p = (u1 == 1.f) ? e1 : __logf(u1) * (e1 / (u1 - 1.f));
    const float c8 = -8.f * (fmaxf(-lamv, 0.f) + l1p);
    const float c8l2 = c8 * 1.44269504f, nba = -1.44269504f * ba, nbx = -1.44269504f * bx;
    float carry = lat ? GIN(3)[((sq - 16) * 2 + l) * 2 * WB + dr * WB + ch] : 0.f;
    const int cg = F.tid & 15; float cw[4][8], cb[8];
#pragma unroll
    for (int e = 0; e < 8; ++e) { cb[e] = GIN(22)[l * WB + 128 * n + 8 * cg + e];
#pragma unroll
        for (int k = 0; k < 4; ++k) cw[k][e] = GIN(21)[(l * 4 + k) * WB + 128 * n + 8 * cg + e]; }
    const GAS bf16* XB = WSP(bf16, WS_PROJ) + 2 * SEG_ELEMS;
    GAS bf16* HL = WSP(bf16, WS_HL) + (size_t)dr * SEG_ELEMS;
    for (int pp = 0; pp < npan; ++pp) {
        const int m0 = mbase + 256 * (dr ? npan - 1 - pp : pp);
        __syncthreads();
#pragma unroll 2
        for (int it = 0; it < 8; ++it) { const int t = (F.tid >> 4) + 32 * it;
            float o[8];
#pragma unroll
            for (int e = 0; e < 8; ++e) o[e] = cb[e];
#pragma unroll
            for (int k = 0; k < 4; ++k) { const int ts = t + k - 2; const bool ok = lat ? ((ts >= 0) && ((ts >> 6) == (t >> 6))) : (ts >= 0 && ts < 256);
                if (ok) { const u32x4 xv = *(const GAS u32x4*)(XB + (size_t)(m0 + ts) * WB + 128 * n + 8 * cg);
                    o[0] += cw[k][0] * bflo(xv.x); o[1] += cw[k][1] * bfhi(xv.x); o[2] += cw[k][2] * bflo(xv.y); o[3] += cw[k][3] * bfhi(xv.y);
                    o[4] += cw[k][4] * bflo(xv.z); o[5] += cw[k][5] * bfhi(xv.z); o[6] += cw[k][6] * bflo(xv.w); o[7] += cw[k][7] * bfhi(xv.w); } }
            u32x4 wv; wv.x = cvt_pk_bf16(o[0], o[1]); wv.y = cvt_pk_bf16(o[2], o[3]); wv.z = cvt_pk_bf16(o[4], o[5]); wv.w = cvt_pk_bf16(o[6], o[7]);
            *(LAS u32x4*)(XC + t * 136 + 8 * cg) = wv; }
        __syncthreads();
#pragma unroll 1
        for (int hh = 0; hh < 2; ++hh) {
            const int half = dr ? 1 - hh : hh;
            f32x4 R[8], I[8];
#pragma unroll
            for (int mt = 0; mt < 8; ++mt) { R[mt] = (f32x4){0.f, 0.f, 0.f, 0.f}; I[mt] = (f32x4){0.f, 0.f, 0.f, 0.f}; }
#pragma unroll
            for (int ks = 0; ks < 4; ++ks)
#pragma unroll
                for (int mt = 0; mt < 8; ++mt) { const bf16x8 af = *(const LAS bf16x8*)(XC + (128 * half + 16 * mt + r) * 136 + 32 * ks + 8 * q);
                    R[mt] = __builtin_amdgcn_mfma_f32_16x16x32_bf16(af, wa[ks], R[mt], 0, 0, 0); I[mt] = __builtin_amdgcn_mfma_f32_16x16x32_bf16(af, wx[ks], I[mt], 0, 0, 0); }
#pragma unroll
            for (int mi = 0; mi < 8; ++mi) {
                const int mt = dr ? 7 - mi : mi; const int tb = 128 * half + 16 * mt + 4 * q;
                f32x4 a, b;
                { const f32x4 er_ = R[mt] * (-1.44269504f) + nba, ei_ = I[mt] * (-1.44269504f) + nbx; f32x4 dr_, di_, xc_;
#pragma unroll
                  for (int i = 0; i < 4; ++i) { dr_[i] = __builtin_amdgcn_exp2f(er_[i]); di_[i] = __builtin_amdgcn_exp2f(ei_[i]); xc_[i] = bf2f(XC[(tb + i) * 136 + d]); }
                  dr_ = dr_ + 1.f; di_ = di_ + 1.f; f32x4 rr, ig;
#pragma unroll
                  for (int i = 0; i < 4; ++i) { rr[i] = frcp(dr_[i]); ig[i] = frcp(di_[i]); }
                  const f32x4 la2 = rr * c8l2;
#pragma unroll
                  for (int i = 0; i < 4; ++i) a[i] = __builtin_amdgcn_exp2f(la2[i]);
                  f32x4 m2 = 1.f - a * a;
#pragma unroll
                  for (int i = 0; i < 4; ++i) m2[i] = __builtin_amdgcn_sqrtf(fmaxf(m2[i], 0.f));
                  b = m2 * ig * xc_; }
                float PA[4], PB[4], h[4];
                if (!dr) { PA[0] = a[0]; PB[0] = b[0];
#pragma unroll
                    for (int i = 1; i < 4; ++i) { PA[i] = a[i] * PA[i - 1]; PB[i] = a[i] * PB[i - 1] + b[i]; } }
                else { PA[3] = a[3]; PB[3] = b[3];
#pragma unroll
                    for (int i = 2; i >= 0; --i) { PA[i] = a[i] * PA[i + 1]; PB[i] = a[i] * PB[i + 1] + b[i]; } }
                const float TA = dr ? PA[0] : PA[3], TB = dr ? PB[0] : PB[3];
                const int qq = dr ? 3 - q : q;
                float pa = dr ? SHFL_DOWN(TA, 16, F.lane) : SHFL_UP(TA, 16, F.lane), pb = dr ? SHFL_DOWN(TB, 16, F.lane) : SHFL_UP(TB, 16, F.lane);
                float S1A = TA, S1B = TB; if (qq >= 1) { S1A = TA * pa; S1B = TA * pb + TB; }
                pa = dr ? SHFL_DOWN(S1A, 32, F.lane) : SHFL_UP(S1A, 32, F.lane); pb = dr ? SHFL_DOWN(S1B, 32, F.lane) : SHFL_UP(S1B, 32, F.lane);
                float IA = S1A, IB = S1B; if (qq >= 2) { IA = S1A * pa; IB = S1A * pb + S1B; }
                pa = dr ? SHFL_DOWN(IA, 16, F.lane) : SHFL_UP(IA, 16, F.lane); pb = dr ? SHFL_DOWN(IB, 16, F.lane) : SHFL_UP(IB, 16, F.lane);
                float EA = 1.f, EB = 0.f; if (qq >= 1) { EA = pa; EB = pb; }
                const float TTA = shfl_src(IA, (dr ? 0 : 48) + r), TTB = shfl_src(IB, (dr ? 0 : 48) + r);
                const float sin_ = EA * carry + EB;
#pragma unroll
                for (int i = 0; i < 4; ++i) { h[i] = PA[i] * sin_ + PB[i]; HL[(size_t)(m0 + tb + i) * WB + ch] = f2bf(h[i]); }
                carry = TTA * carry + TTB;
            }
        }
    }
    if (!lat && q == 0) GOUT[26214400 + ((sq * 2 + l) * 2 + dr) * WB + ch] = carry;
    __syncthreads();
}
__device__ __forceinline__ void hgrn_unit(const Frame& F, int l, int sq, int hd, int dr) {
    const int lane = F.lane, r = lane & 15, q = lane >> 4, w = F.wave, tid = F.tid;
    const bool lat = sq >= 16; const int L = lat ? 1024 : 256, mbase = lat ? NCTX + (sq - 16) * 1024 : sq * 256, nch = L / 16;
    constexpr int HG_BUF = 22528;
    const GAS bf16* QC = WSP(bf16, WS_PROJ) + 4 * SEG_ELEMS; const GAS bf16* FC = WSP(bf16, WS_PROJ) + (size_t)(5 + dr) * SEG_ELEMS; const GAS bf16* IC = WSP(bf16, WS_PROJ) + 7 * SEG_ELEMS;
    GAS bf16* O = WSP(bf16, WS_O) + (size_t)dr * SEG_ELEMS;
    const int k = 16 * w + r, chk = hd * 128 + k;
    float lb = 0.f; if (l == 1) lb = sigm(GIN(28)[(2 + dr) * WB + chk] - GIN(28)[dr * WB + chk]);
    f32x4 S[8];
    if (lat) { const GAS float* st = GIN(4) + ((size_t)((((sq - 16) * 2 + l) * 2 + dr) * 16 + hd) * 128) * 128 + 16 * w + r;
#pragma unroll
        for (int kt = 0; kt < 8; ++kt)
#pragma unroll
            for (int i = 0; i < 4; ++i) S[kt][i] = st[(size_t)(16 * kt + 4 * q + i) * 128]; }
    else {
#pragma unroll
        for (int kt = 0; kt < 8; ++kt) S[kt] = (f32x4){0.f, 0.f, 0.f, 0.f}; }
    bf16 fraw[4], qraw[4]; u32x2 vraw;
    const int vs = tid >> 5, v4 = 4 * (tid & 31);
#define HG_LOAD(c_) do { _Pragma("unroll") for (int jj = 0; jj < 4; ++jj) { const int j_ = 16 * (c_) + 4 * q + jj; const int m_ = mbase + (dr ? L - 1 - j_ : j_); \
            fraw[jj] = FC[(size_t)m_ * WB + chk]; qraw[jj] = QC[(size_t)m_ * WB + chk]; } \
        { const int j_ = 16 * (c_) + vs; const int m_ = mbase + (dr ? L - 1 - j_ : j_); vraw = *(const GAS u32x2*)(IC + (size_t)m_ * WB + hd * 128 + v4); } } while (0)
#define HG_PREP(c_, BO_) do { LAS bf16* QE_ = (LAS bf16*)(F.lds + (BO_)); LAS bf16* KE_ = (LAS bf16*)(F.lds + (BO_) + 4352); LAS bf16* KDT_ = (LAS bf16*)(F.lds + (BO_) + 8704); \
        LAS bf16* VT_ = (LAS bf16*)(F.lds + (BO_) + 14848); LAS float* DL_ = (LAS float*)(F.lds + (BO_) + 20992); \
          \
        float gg[4], gi[4], kk[4], qv[4]; \
        _Pragma("unroll") for (int jj = 0; jj < 4; ++jj) { const float f = bf2f(fraw[jj]); qv[jj] = bf2f(qraw[jj]); const float e = fminf(__builtin_amdgcn_exp2f(f * (-1.44269504f)), 1e30f); \
            const float d = 1.f + e, n = 1.f + lb * e; const float g = n * frcp(d); gg[jj] = g; gi[jj] = lb == 0.f ? d : d * frcp(n); kk[jj] = 1.f - g; } \
        const u32x2 vv = vraw; \
        if ((c_) + 1 < nch) HG_LOAD((c_) + 1); \
        float pg[4], pd[4]; pg[0] = gg[0]; pg[1] = pg[0] * gg[1]; pg[2] = pg[1] * gg[2]; pg[3] = pg[2] * gg[3]; pd[0] = gi[0]; pd[1] = pd[0] * gi[1]; pd[2] = pd[1] * gi[2]; pd[3] = pd[2] * gi[3]; \
        const float Tg = pg[3], Td = pd[3]; \
        const float a1 = SHFL_UP(Tg, 16, F.lane), b1 = SHFL_UP(Td, 16, F.lane); const float i1g = q >= 1 ? Tg * a1 : Tg, i1d = q >= 1 ? Td * b1 : Td; \
        const float a2 = SHFL_UP(i1g, 32, F.lane), b2 = SHFL_UP(i1d, 32, F.lane); const float incg = q >= 2 ? i1g * a2 : i1g, incd = q >= 2 ? i1d * b2 : i1d; \
        const float a3 = SHFL_UP(incg, 16, F.lane), b3 = SHFL_UP(incd, 16, F.lane); const float excg = q >= 1 ? a3 : 1.f, excd = q >= 1 ? b3 : 1.f; \
        const float dlv = shfl_src(incg, 48 + r); \
        _Pragma("unroll") for (int jj = 0; jj < 4; ++jj) { const int j = 4 * q + jj; const float kev = kk[jj] * fminf(excd * pd[jj], 1e35f); \
            QE_[j * 136 + k] = f2bf(qv[jj] * (excg * pg[jj])); KE_[j * 136 + k] = f2bf(kev); KDT_[k * 24 + j] = f2bf(kev * dlv); } \
        if (q == 0) DL_[k] = dlv; \
        VT_[(v4 + 0) * 24 + vs] = (bf16)(vv.x & 0xffffu); VT_[(v4 + 1) * 24 + vs] = (bf16)(vv.x >> 16); VT_[(v4 + 2) * 24 + vs] = (bf16)(vv.y & 0xffffu); VT_[(v4 + 3) * 24 + vs] = (bf16)(vv.y >> 16); } while (0)
    HG_LOAD(0);
    HG_PREP(0, 0);
    __syncthreads();
    for (int c = 0; c < nch; ++c) {
        const int bo = (c & 1) * HG_BUF;
        if (c + 1 < nch) HG_PREP(c + 1, HG_BUF - bo);
        LAS bf16* QE = (LAS bf16*)(F.lds + bo); LAS bf16* KE = (LAS bf16*)(F.lds + bo + 4352); LAS bf16* KDT = (LAS bf16*)(F.lds + bo + 8704); LAS bf16* VT = (LAS bf16*)(F.lds + bo + 14848); LAS float* DL = (LAS float*)(F.lds + bo + 20992);
        f32x4 pt = {0.f, 0.f, 0.f, 0.f};
#pragma unroll
        for (int ks = 0; ks < 4; ++ks) { const bf16x8 ka = *(const LAS bf16x8*)(KE + r * 136 + 32 * ks + 8 * q), qb = *(const LAS bf16x8*)(QE + r * 136 + 32 * ks + 8 * q);
            pt = __builtin_amdgcn_mfma_f32_16x16x32_bf16(ka, qb, pt, 0, 0, 0); }
#pragma unroll
        for (int i = 0; i < 4; ++i) if (4 * q + i > r) pt[i] = 0.f;
        u32x4 pw = {cvt_pk_bf16(pt[0], pt[1]), cvt_pk_bf16(pt[2], pt[3]), 0u, 0u};
        u32x4 vw = {0u, 0u, 0u, 0u}; { const u32x2 t2 = *(const LAS u32x2*)(VT + (16 * w + r) * 24 + 4 * q); vw.x = t2.x; vw.y = t2.y; }
        f32x4 o = __builtin_amdgcn_mfma_f32_16x16x32_bf16(__builtin_bit_cast(bf16x8, pw), __builtin_bit_cast(bf16x8, vw), (f32x4){0.f, 0.f, 0.f, 0.f}, 0, 0, 0);
#pragma unroll
        for (int ks = 0; ks < 4; ++ks) {
            const u32x2 qa0 = *(const LAS u32x2*)(QE + r * 136 + 32 * ks + 4 * q), qa1 = *(const LAS u32x2*)(QE + r * 136 + 32 * ks + 16 + 4 * q);
            const u32x4 qa = {qa0.x, qa0.y, qa1.x, qa1.y};
            const u32x4 sb = {cvt_pk_bf16(S[2 * ks][0], S[2 * ks][1]), cvt_pk_bf16(S[2 * ks][2], S[2 * ks][3]), cvt_pk_bf16(S[2 * ks + 1][0], S[2 * ks + 1][1]), cvt_pk_bf16(S[2 * ks + 1][2], S[2 * ks + 1][3])};
            o = __builtin_amdgcn_mfma_f32_16x16x32_bf16(__builtin_bit_cast(bf16x8, qa), __builtin_bit_cast(bf16x8, sb), o, 0, 0, 0);
        }
#pragma unroll
        for (int i = 0; i < 4; ++i) { const int j = 16 * c + 4 * q + i; const int m = mbase + (dr ? L - 1 - j : j); O[(size_t)m * WB + hd * 128 + 16 * w + r] = f2bf(o[i]); }
        u32x4 vb = {0u, 0u, 0u, 0u}; if (q < 2) vb = *(const LAS u32x4*)(VT + (16 * w + r) * 24 + 8 * q);
#pragma unroll
        for (int kt = 0; kt < 8; ++kt) {
            const f32x4 dl = *(const LAS f32x4*)(DL + 16 * kt + 4 * q);
            u32x4 ka = {0u, 0u, 0u, 0u}; if (q < 2) ka = *(const LAS u32x4*)(KDT + (16 * kt + r) * 24 + 8 * q);
            S[kt] = __builtin_amdgcn_mfma_f32_16x16x32_bf16(__builtin_bit_cast(bf16x8, ka), __builtin_bit_cast(bf16x8, vb), S[kt] * dl, 0, 0, 0);
        }
        __syncthreads();
    }
    if (!lat) { GAS float* st = GOUT + 26345472 + ((size_t)(((sq * 2 + l) * 2 + dr) * 16 + hd) * 128) * 128 + 16 * w + r;
#pragma unroll
        for (int kt = 0; kt < 8; ++kt)
#pragma unroll
            for (int i = 0; i < 4; ++i) st[(size_t)(16 * kt + 4 * q + i) * 128] = S[kt][i]; }
#undef HG_LOAD
#undef HG_PREP
}
#define MIXQ_LOOP(HEAD, N, NLONG, BODY) { __syncthreads(); if (F.tid == 0) qw[0] = (int)__hip_atomic_fetch_add((HEAD), 1u, __ATOMIC_RELAXED, __HIP_MEMORY_SCOPE_AGENT); __syncthreads(); \
        int u = __builtin_amdgcn_readfirstlane(qw[0]); \
        while (u < (N)) { const bool pre_ = u >= (NLONG); unsigned nx_ = 0u; if (pre_ && F.tid == 0) nx_ = __hip_atomic_fetch_add((HEAD), 1u, __ATOMIC_RELAXED, __HIP_MEMORY_SCOPE_AGENT); \
            BODY \
            __syncthreads(); if (F.tid == 0) qw[0] = pre_ ? (int)nx_ : (int)__hip_atomic_fetch_add((HEAD), 1u, __ATOMIC_RELAXED, __HIP_MEMORY_SCOPE_AGENT); __syncthreads(); \
            u = __builtin_amdgcn_readfirstlane(qw[0]); } }
__device__ __forceinline__ void mixers_phase(const Frame& F0_, int l, GAS unsigned* qhead) {
    volatile LAS int* qw = (volatile LAS int*)(F0_.lds + LDSCTL_OFF + 256);
    const int vl_ = F0_.vcu & 31;
    const int cls = F0_.G == 256 ? (vl_ < 8 ? 0 : (vl_ < 16 ? 1 : 2)) : 3;
#pragma unroll 1
    for (int pass = 0; pass < 2; ++pass) {
        const int ps = launder_s(pass);
        for (int rp = 0; rp < (int)((PROBE_MASK >> 16) & 1u) + 1; ++rp) { const Frame F = launder(F0_); if (ps == 1 || cls >= 2) { MIXQ_LOOP(qhead + 64 + 16 * rp, 192, 0, { s5_wg_unit(F, l, u); }) } }
        for (int rp = 0; rp < (int)((PROBE_MASK >> 18) & 1u) + 1; ++rp) { const Frame F = launder(F0_); GAS unsigned* hd_ = (ps == 0 ? qhead + 32 : qhead + 128) + 16 * rp; const int n_ = ps == 0 ? 64 : 512, base_ = ps == 0 ? 0 : 64, nl_ = ps == 0 ? 64 : 0;
          if (ps == 1 || cls == 1 || cls == 3) { MIXQ_LOOP(hd_, n_, nl_, { const int ub = u + base_; if (ub < 64) hgrn_unit(F, l, 16 + (ub >> 5), (ub >> 1) & 15, ub & 1); else { const int j = ub - 64; hgrn_unit(F, l, j >> 5, (j >> 1) & 15, j & 1); } }) } }
        for (int rp = 0; rp < (int)((PROBE_MASK >> 17) & 1u) + 1; ++rp) { const Frame F = launder(F0_); GAS unsigned* hd_ = (ps == 0 ? qhead : qhead + 96) + 16 * rp; const int n_ = ps == 0 ? 64 : 512, base_ = ps == 0 ? 0 : 64, nl_ = ps == 0 ? 64 : 0;
          if (ps == 1 || cls == 0 || cls == 3) { MIXQ_LOOP(hd_, n_, nl_, { const int ub = u + base_; if (ub < 64) lru_unit(F, l, 16 + (ub >> 5), (ub >> 1) & 15, ub & 1); else { const int j = ub - 64; lru_unit(F, l, j >> 5, (j >> 1) & 15, j & 1); } }) } }
    }
    __syncthreads();
}

__device__ __forceinline__ void combine_phase(const Frame& F, int l) {
    const int gw = F.vcu * 8 + F.wave, NGW = F.G * 8, lane = F.lane;
    const GAS bf16* Y0 = WSP(bf16, WS_YS5); const GAS bf16* Y1 = Y0 + SEG_ELEMS; const GAS bf16* H0 = WSP(bf16, WS_HL); const GAS bf16* H1 = H0 + SEG_ELEMS; const GAS bf16* O0 = WSP(bf16, WS_O); const GAS bf16* O1 = O0 + SEG_ELEMS;
    const GAS bf16* UA = WSP(bf16, WS_PROJ); const GAS bf16* GB = UA + 3 * SEG_ELEMS; const GAS bf16* GC = UA + 8 * SEG_ELEMS;
    GAS bf16* YAP = WSP(bf16, WS_YAP); GAS bf16* YB = WSP(bf16, WS_YABC) + SEG_ELEMS; GAS bf16* YC = WSP(bf16, WS_YABC) + 2 * SEG_ELEMS;
    const GAS float* dsk = GIN(18) + (size_t)l * WB; const GAS float* nw = GIN(29) + (size_t)l * WB;
    for (int m = gw; m < NTOK; m += NGW) {
        const size_t ro = (size_t)m * WB;
        u32x4 ya[4], yb[4], uv[4], ha[4], hb[4], gb[4], oa[4], ob[4], gc[4];
#pragma unroll
        for (int j = 0; j < 4; ++j) { const size_t o = ro + 512 * j + 8 * lane;
            ya[j] = *(const GAS u32x4*)(Y0 + o); yb[j] = *(const GAS u32x4*)(Y1 + o); uv[j] = *(const GAS u32x4*)(UA + o);
            ha[j] = *(const GAS u32x4*)(H0 + o); hb[j] = *(const GAS u32x4*)(H1 + o); gb[j] = *(const GAS u32x4*)(GB + o);
            oa[j] = *(const GAS u32x4*)(O0 + o); ob[j] = *(const GAS u32x4*)(O1 + o); gc[j] = *(const GAS u32x4*)(GC + o); }
#pragma unroll
        for (int j = 0; j < 4; ++j) { const int ch = 512 * j + 8 * lane; const size_t o = ro + ch;
            { const f32x4 d0 = *(const GAS f32x4*)(dsk + ch), d1 = *(const GAS f32x4*)(dsk + ch + 4); u32x4 wv;
#pragma unroll
              for (int q = 0; q < 4; ++q) { const float dl = q < 2 ? d0[2 * q] : d1[2 * q - 4], dh = q < 2 ? d0[2 * q + 1] : d1[2 * q - 3];
                  wv[q] = cvt_pk_bf16(gelu_tanh(bflo(ya[j][q]) + bflo(yb[j][q]) + dl * bflo(uv[j][q])), gelu_tanh(bfhi(ya[j][q]) + bfhi(yb[j][q]) + dh * bfhi(uv[j][q]))); }
              *(GAS u32x4*)(YAP + o) = wv;
              int w0 = 0, w1 = 0;
              w0 = __builtin_amdgcn_cvt_pk_fp8_f32(__builtin_amdgcn_fmed3f(bflo(wv[0]), -448.f, 448.f), __builtin_amdgcn_fmed3f(bfhi(wv[0]), -448.f, 448.f), w0, false);
              w0 = __builtin_amdgcn_cvt_pk_fp8_f32(__builtin_amdgcn_fmed3f(bflo(wv[1]), -448.f, 448.f), __builtin_amdgcn_fmed3f(bfhi(wv[1]), -448.f, 448.f), w0, true);
              w1 = __builtin_amdgcn_cvt_pk_fp8_f32(__builtin_amdgcn_fmed3f(bflo(wv[2]), -448.f, 448.f), __builtin_amdgcn_fmed3f(bfhi(wv[2]), -448.f, 448.f), w1, false);
              w1 = __builtin_amdgcn_cvt_pk_fp8_f32(__builtin_amdgcn_fmed3f(bflo(wv[3]), -448.f, 448.f), __builtin_amdgcn_fmed3f(bfhi(wv[3]), -448.f, 448.f), w1, true);
              u32x2 w8; w8.x = (unsigned)w0; w8.y = (unsigned)w1; *(GAS u32x2*)(WSP(unsigned char, WS_TMP) + 32 * MiB + o) = w8; }
            { u32x4 wv;
#pragma unroll
              for (int q = 0; q < 4; ++q) wv[q] = cvt_pk_bf16((bflo(ha[j][q]) + bflo(hb[j][q])) * bflo(gb[j][q]), (bfhi(ha[j][q]) + bfhi(hb[j][q])) * bfhi(gb[j][q]));
              *(GAS u32x4*)(YB + o) = wv; }
            { const f32x4 w0 = *(const GAS f32x4*)(nw + ch), w1 = *(const GAS f32x4*)(nw + ch + 4); float ol[4], oh[4], ss = 0.f;
#pragma unroll
              for (int q = 0; q < 4; ++q) { ol[q] = bflo(oa[j][q]) + bflo(ob[j][q]); oh[q] = bfhi(oa[j][q]) + bfhi(ob[j][q]); ss += ol[q] * ol[q] + oh[q] * oh[q]; }
#pragma unroll
              for (int sft = 1; sft < 16; sft <<= 1) ss += SHFL_XOR(ss, sft, lane);
              const float rs = 1.f / sqrtf(ss * (1.f / 128.f) + RMS_EPS); u32x4 wv;
#pragma unroll
              for (int q = 0; q < 4; ++q) { const float wl = q < 2 ? w0[2 * q] : w1[2 * q - 4], wh = q < 2 ? w0[2 * q + 1] : w1[2 * q - 3];
                  wv[q] = cvt_pk_bf16(ol[q] * rs * wl * bflo(gc[j][q]), oh[q] * rs * wh * bfhi(gc[j][q])); }
              *(GAS u32x4*)(YC + o) = wv; }
        }
    }
}

constexpr int N_PHASES = 16;
__global__ void __launch_bounds__(512, 2) fwd_kernel(Args args) {
    extern __shared__ __attribute__((aligned(16))) unsigned char lds_raw[];
    Frame F0;
    F0.lds = (LAS unsigned char*)lds_raw; F0.tid = threadIdx.x; F0.lane = F0.tid & 63; F0.wave = __builtin_amdgcn_readfirstlane(F0.tid >> 6);
    F0.G = gridDim.x; { const int bx = blockIdx.x; F0.vcu = (F0.G % 8 == 0) ? (bx % 8) * (F0.G / 8) + bx / 8 : bx; }
    F0.in = args.in; F0.out = args.out; F0.ws = args.ws;
    for (int u = F0.tid; u < (LDS_BYTES - LDSCTL_OFF) / 4; u += 512) ((LAS unsigned*)(F0.lds + LDSCTL_OFF))[u] = 0u;
    __syncthreads();
    const int lo = args.ph_lo, hi = args.ph_hi;
    XcdBarrier bar; bar.bar = (unsigned*)(F0.ws + WS_CTL) + CW_BAR; bar.x = 0; bar.st = nullptr;
    if (hi - lo > 1) bar = xcd_barrier_post((unsigned*)(F0.ws + WS_CTL) + CW_BAR, (volatile LAS unsigned*)(F0.lds + LDSCTL_OFF + 64));
#define IN(k) (lo <= (k) && (k) < hi)
#define SEAM(k) do { if (IN(k) && IN((k) + 1)) xcd_barrier(bar); } while (0)

    if (IN(0)) REP(0) { const Frame P = launder(F0); p0_prologue(P); } SEAM(0);
#pragma unroll 1
    for (int l0 = 0; l0 < 2; ++l0) {
        const int pb = 1 + 7 * l0;
        if (IN(pb)) REP(pb) { const Frame P = launder(F0); const int l = launder_s(l0); if (l == 0) ln_phase<0>(P, 0); else ln_phase<1>(P, 1); } SEAM(pb);
        if (IN(pb + 1)) REP(pb + 1) {
#ifndef NO_G1
            { const Frame F = launder(F0); const int l = launder_s(l0);
              pg8::Gemm g{WSP(bf16, WS_H), (const GAS bf16*)(WSP(unsigned char, WS_WIN) + (size_t)l * (240 * MiB)), NTOK, 9 * WB, D};
              typedef pg8::StreamOrder<24, 72, 64> Ord; Ord S; S.init(F.G, launder_s((int)blockIdx.x), EpiProj::NSLAB);
              const SplitCtx sx{WSP(float, WS_SLAB), WSP(unsigned, WS_CTL) + CW_CNT + (pb + 1) * 8192, WSP(unsigned, WS_CTL) + CW_TMO, 1};
              EpiProj E{WSP(bf16, WS_PROJ), GIN(10) + (size_t)l * INC, sx, 0};
              pg8::gemm_phase<EpiProj, Ord, true, true, false>(F.lds, g, S, E, F.tid); }
            { const Frame F = launder(F0); const int l = launder_s(l0);
              pg8::Gemm g{(const GAS bf16*)WSP(unsigned char, WS_TMP), (const GAS bf16*)(WSP(unsigned char, WS_WIN) + (size_t)l * (240 * MiB) + 144 * MiB), NTOK, 6 * WB, D / 2};
              typedef pg8::TailOrder<24, 48, 32> Ord8; Ord8 S; S.init(F.G, launder_s((int)blockIdx.x), (24 * 72) % F.G);
              const SplitCtx sx{WSP(float, WS_SLAB), WSP(unsigned, WS_CTL) + CW_CNT + (pb + 1) * 8192, WSP(unsigned, WS_CTL) + CW_TMO, 1};
              EpiProj E{WSP(bf16, WS_PROJ), GIN(10) + (size_t)l * INC, sx, 1};
              pg8::gemm_phase<EpiProj, Ord8, true, true, true>(F.lds, g, S, E, F.tid); }
#endif
        } SEAM(pb + 1);
        if (IN(pb + 2)) REP(pb + 2) { { const Frame P = launder(F0); mixers_phase(P, launder_s(l0), (GAS unsigned*)(P.ws + WS_CTL) + CW_MIXQ + 256 * l0 + 512 * _r); } } SEAM(pb + 2);
        if (IN(pb + 3)) REP(pb + 3) { const Frame P = launder(F0); combine_phase(P, launder_s(l0)); } SEAM(pb + 3);
        if (IN(pb + 4)) REP(pb + 4) { const Frame F = launder(F0); const int l = launder_s(l0);
            pg8::Gemm g{(const GAS bf16*)(WSP(unsigned char, WS_TMP) + 32 * MiB), WSP(bf16, WS_WGLU) + (size_t)l * WB * WB, NTOK, WB, WB / 2}; typedef pg8::StreamOrder<24, 8, 16> Ord; Ord S; S.init(F.G, launder_s((int)blockIdx.x), EpiGlu::NSLAB);
            const SplitCtx sx{WSP(float, WS_SLAB), WSP(unsigned, WS_CTL) + CW_CNT + (pb + 4) * 8192, WSP(unsigned, WS_CTL) + CW_TMO, S.s - 1};
            EpiGlu E{WSP(bf16, WS_YAP), WSP(bf16, WS_PROJ) + SEG_ELEMS, WSP(bf16, WS_YABC), GIN(20) + (size_t)l * WB, sx};
#ifndef NO_G2
            pg8::gemm_phase<EpiGlu, Ord, true, true, true>(F.lds, g, S, E, F.tid);
#endif

        } SEAM(pb + 4);
        if (IN(pb + 5)) REP(pb + 5) { const Frame F = launder(F0); const int l = launder_s(l0);
            pg8::Gemm g{WSP(bf16, WS_YABC), WSP(bf16, WS_WBR) + (size_t)l * 3 * D * WB, 3 * NTOK, 3 * D, WB}; pg8::MergeOrder S; S.init(F.G, launder_s((int)blockIdx.x));
            const SplitCtx sx{WSP(float, WS_SLAB), WSP(unsigned, WS_CTL) + CW_CNT + (pb + 5) * 8192, WSP(unsigned, WS_CTL) + CW_TMO, 1};
            EpiMerge E{WSP(bf16, WS_PROJ), WSP(bf16, WS_MERGED), sx};
#ifndef NO_G3
            pg8::gemm_phase<EpiMerge, pg8::MergeOrder, true, true>(F.lds, g, S, E, F.tid);
#endif

        } SEAM(pb + 5);
        if (IN(pb + 6)) REP(pb + 6) { const Frame F = launder(F0); const int l = launder_s(l0);
            pg8::Gemm g{WSP(bf16, WS_MERGED), WSP(bf16, WS_WOUT) + (size_t)l * D * D, NTOK, D, D}; typedef pg8::StreamOrder<24, 16, 64> Ord; Ord S; S.init(F.G, launder_s((int)blockIdx.x), EpiOut::NSLAB, 1);
            const SplitCtx sx{WSP(float, WS_SLAB), WSP(unsigned, WS_CTL) + CW_CNT + (pb + 6) * 8192, WSP(unsigned, WS_CTL) + CW_TMO, S.s - 1};
            EpiOut E{GIN(32) + (size_t)l * D, WSP(float, WS_MOD) + (size_t)l * 3 * 12288, WSP(bf16, WS_V), sx};
#ifndef NO_G4
            pg8::gemm_phase<EpiOut, Ord, true, true>(F.lds, g, S, E, F.tid);
#endif

        } SEAM(pb + 6);
    }
    if (IN(15)) REP(15) { const Frame P = launder(F0); ln_phase<2>(P, 1); }
#undef IN
#undef SEAM
}

extern "C" void kernel_launch(void* const* d_in, const int* in_sizes, int n_in, void* d_out, int out_size, void* d_ws, size_t ws_size, hipStream_t stream) {
    static int grid = 0;
    if (grid == 0) {
        if (n_in != 35 || out_size != 43122688 || ws_size < WS_END) { fprintf(stderr, "kernel_launch: unexpected shapes: n_in %d out %d ws %zu (need %zu)\n", n_in, out_size, ws_size, (size_t)WS_END); grid = -1; return; }
        int dev = 0, cus = 0, per_cu = 0;
        if (hipGetDevice(&dev) != hipSuccess || hipDeviceGetAttribute(&cus, hipDeviceAttributeMultiprocessorCount, dev) != hipSuccess) { grid = -1; return; }
        if (hipFuncSetAttribute((const void*)fwd_kernel, hipFuncAttributeMaxDynamicSharedMemorySize, LDS_BYTES) != hipSuccess) { fprintf(stderr, "kernel_launch: hipFuncSetAttribute failed\n"); grid = -1; return; }
        if (hipOccupancyMaxActiveBlocksPerMultiprocessor(&per_cu, (const void*)fwd_kernel, 512, LDS_BYTES) != hipSuccess || per_cu < 1) fprintf(stderr, "kernel_launch: occupancy query reports %d\n", per_cu);
        (void)hipGetLastError();
        grid = cus;
    }
    if (grid < 0) return;
    (void)hipMemsetAsync((char*)d_ws + WS_CTL, 0, CTL_ZERO_BYTES, stream);
    Args a{};
    for (int i = 0; i < 35; ++i) a.in[i] = (const float*)d_in[i];
    a.out = (float*)d_out; a.ws = (unsigned char*)d_ws;
    if (MK_N_LAUNCHES == 1) { a.ph_lo = 0; a.ph_hi = N_PHASES; hipLaunchKernelGGL(fwd_kernel, dim3(grid), dim3(512), LDS_BYTES, stream, a); }
    else for (int p = 0; p < N_PHASES; ++p) { a.ph_lo = p; a.ph_hi = p + 1; hipLaunchKernelGGL(fwd_kernel, dim3(grid), dim3(512), LDS_BYTES, stream, a); }
}
```
